# Optimizing an MI355X kernel written in HIP

```python
import math
import jax, jax.numpy as jnp
from jax import lax
import numpy as np

D_MODEL = 1024
BATCH = 2
SEQ = 8192
DEPTH = 1

SSM_WIDTH = D_MODEL // 2
SSM_GROUP = 16
SSM_GROUPS = SSM_WIDTH // SSM_GROUP
SSM_STATE = 64
DT_MIN = 1e-3
DT_MAX = 1e-1
LAMBDA_RE_MAX = -1e-4
HGRN_WIDTH = D_MODEL // 2
HGRN_HEAD_DIM = 128
HGRN_HEADS = HGRN_WIDTH // HGRN_HEAD_DIM
HGRN_CHUNK = 64
NORM_EPS = 1e-6

IN_WIDTH = 2 * SSM_WIDTH + 5 * HGRN_WIDTH + 2 * D_MODEL
SPLIT_POINTS = (
    SSM_WIDTH,
    2 * SSM_WIDTH,
    2 * SSM_WIDTH + HGRN_WIDTH,
    2 * SSM_WIDTH + 2 * HGRN_WIDTH,
    2 * SSM_WIDTH + 3 * HGRN_WIDTH,
    2 * SSM_WIDTH + 4 * HGRN_WIDTH,
    2 * SSM_WIDTH + 5 * HGRN_WIDTH,
    2 * SSM_WIDTH + 5 * HGRN_WIDTH + D_MODEL,
)

kernel_name = 'hybrid_s5_hgrn2_gated_block'


def rms_norm(x, w):
    xf = x.astype(jnp.float32)
    y = xf * lax.rsqrt(jnp.mean(xf * xf, axis=-1, keepdims=True) + NORM_EPS)
    return (y * w.astype(jnp.float32)).astype(x.dtype)


def s5_branch(u, z, lam_re, lam_im, b_re, b_im, c_re, c_im, d, log_dt, w_glu, b_glu):
    f32 = jnp.float32
    bsz, seqlen, _ = u.shape
    ug = u.astype(f32).reshape(bsz, seqlen, SSM_GROUPS, SSM_GROUP)
    lr = jnp.minimum(lam_re.astype(f32), LAMBDA_RE_MAX)
    li = lam_im.astype(f32)
    dt = jnp.exp(log_dt.astype(f32))[:, None]
    mag = jnp.exp(lr * dt)
    ab_re = mag * jnp.cos(li * dt)
    ab_im = mag * jnp.sin(li * dt)
    den = lr * lr + li * li
    nr = ab_re - 1.0
    coef_re = (nr * lr + ab_im * li) / den
    coef_im = (ab_im * lr - nr * li) / den
    br = b_re.astype(f32)
    bi = b_im.astype(f32)
    bb_re = coef_re[..., None] * br - coef_im[..., None] * bi
    bb_im = coef_re[..., None] * bi + coef_im[..., None] * br
    bu_re = jnp.einsum('blgp,gnp->blgn', ug, bb_re)
    bu_im = jnp.einsum('blgp,gnp->blgn', ug, bb_im)
    a_re = jnp.broadcast_to(ab_re, bu_re.shape)
    a_im = jnp.broadcast_to(ab_im, bu_im.shape)

    def combine(e1, e2):
        a1r, a1i, b1r, b1i = e1
        a2r, a2i, b2r, b2i = e2
        return (a2r * a1r - a2i * a1i,
                a2r * a1i + a2i * a1r,
                a2r * b1r - a2i * b1i + b2r,
                a2r * b1i + a2i * b1r + b2i)

    _, _, h_re, h_im = lax.associative_scan(combine, (a_re, a_im, bu_re, bu_im), axis=1)
    y = (jnp.einsum('blgn,gpn->blgp', h_re, c_re.astype(f32))
         - jnp.einsum('blgn,gpn->blgp', h_im, c_im.astype(f32))
         + d.astype(f32) * ug)
    y = jax.nn.gelu(y.reshape(bsz, seqlen, SSM_WIDTH))
    y = y * jax.nn.sigmoid(y @ w_glu.astype(f32) + b_glu.astype(f32))
    return y * jax.nn.silu(z.astype(f32))


def hgrn2_branch(q, f, i, og, z, lower_bound, head_norm_w):
    f32 = jnp.float32
    bsz, seqlen, _ = q.shape
    n_chunks = seqlen // HGRN_CHUNK

    def to_chunks(t):
        return t.reshape(bsz, n_chunks, HGRN_CHUNK, HGRN_HEADS, HGRN_HEAD_DIM).transpose(1, 0, 3, 2, 4)

    qf = jax.nn.silu(q.astype(f32))
    forget = lower_bound + (1.0 - lower_bound) * jax.nn.sigmoid(f.astype(f32))
    log_f = jnp.log(forget)
    key = 1.0 - forget
    causal = jnp.tril(jnp.ones((HGRN_CHUNK, HGRN_CHUNK), dtype=bool))[:, :, None]

    def step(state, inp):
        qc, kc, vc, gc = inp
        cum = jnp.cumsum(gc, axis=2)
        o_inter = jnp.einsum('bhtk,bhkv->bhtv', qc * jnp.exp(cum), state)
        diff = cum[:, :, :, None, :] - cum[:, :, None, :, :]
        decay = jnp.exp(jnp.where(causal, diff, -jnp.inf))
        scores = jnp.einsum('bhtk,bhsk,bhtsk->bhts', qc, kc, decay)
        o_intra = jnp.einsum('bhts,bhsv->bhtv', scores, vc)
        last = cum[:, :, -1:, :]
        new_state = (jnp.exp(last[:, :, 0, :])[..., None] * state
                     + jnp.einsum('bhsk,bhsv->bhkv', kc * jnp.exp(last - cum), vc))
        return new_state, o_inter + o_intra

    s0 = jnp.zeros((bsz, HGRN_HEADS, HGRN_HEAD_DIM, HGRN_HEAD_DIM), f32)
    _, o = lax.scan(step, s0, (to_chunks(qf), to_chunks(key), to_chunks(i.astype(f32)), to_chunks(log_f)))
    o = o.transpose(1, 0, 3, 2, 4).reshape(bsz, seqlen, HGRN_HEADS, HGRN_HEAD_DIM)
    o = o * jax.nn.sigmoid(og.astype(f32)).reshape(bsz, seqlen, HGRN_HEADS, HGRN_HEAD_DIM)
    o = o * lax.rsqrt(jnp.mean(o * o, axis=-1, keepdims=True) + NORM_EPS)
    o = o * head_norm_w.astype(f32).reshape(HGRN_HEADS, HGRN_HEAD_DIM)
    o = o.reshape(bsz, seqlen, HGRN_WIDTH)
    return o * jax.nn.silu(z.astype(f32))


def setup_inputs(seed: int = 0) -> dict:
    key = jax.random.key(seed)
    ks = jax.random.split(key, 24)
    nrm = jax.random.normal
    f32 = jnp.float32
    n_idx = jnp.arange(SSM_STATE, dtype=f32)
    x = nrm(ks[0], (BATCH, SEQ, D_MODEL), f32)
    norm_w = 1.0 + 0.01 * nrm(ks[1], (DEPTH, D_MODEL), f32)
    w_in = nrm(ks[2], (DEPTH, D_MODEL, IN_WIDTH), f32) * D_MODEL ** -0.5
    ssm_lambda_re = -0.5 + 0.01 * nrm(ks[3], (DEPTH, SSM_GROUPS, SSM_STATE), f32)
    ssm_lambda_im = math.pi * n_idx + 0.01 * nrm(ks[4], (DEPTH, SSM_GROUPS, SSM_STATE), f32)
    ssm_b_re = nrm(ks[5], (DEPTH, SSM_GROUPS, SSM_STATE, SSM_GROUP), f32) * (2 * SSM_GROUP) ** -0.5
    ssm_b_im = nrm(ks[6], (DEPTH, SSM_GROUPS, SSM_STATE, SSM_GROUP), f32) * (2 * SSM_GROUP) ** -0.5
    ssm_c_re = nrm(ks[7], (DEPTH, SSM_GROUPS, SSM_GROUP, SSM_STATE), f32) * (2 * SSM_STATE) ** -0.5
    ssm_c_im = nrm(ks[8], (DEPTH, SSM_GROUPS, SSM_GROUP, SSM_STATE), f32) * (2 * SSM_STATE) ** -0.5
    ssm_d = nrm(ks[9], (DEPTH, SSM_GROUPS, SSM_GROUP), f32)
    ssm_log_dt = jax.random.uniform(ks[10], (DEPTH, SSM_GROUPS), f32,
                                    minval=math.log(DT_MIN), maxval=math.log(DT_MAX))
    ssm_w_glu = nrm(ks[11], (DEPTH, SSM_WIDTH, SSM_WIDTH), f32) * SSM_WIDTH ** -0.5
    ssm_b_glu = 0.01 * nrm(ks[12], (DEPTH, SSM_WIDTH), f32)
    hgrn_lb_logits = 0.1 * nrm(ks[13], (DEPTH + 1, HGRN_WIDTH), f32)
    hgrn_norm_w = 1.0 + 0.01 * nrm(ks[14], (DEPTH, HGRN_WIDTH), f32)
    w_proj_a = nrm(ks[15], (DEPTH, SSM_WIDTH, D_MODEL), f32) * SSM_WIDTH ** -0.5
    w_proj_b = nrm(ks[16], (DEPTH, HGRN_WIDTH, D_MODEL), f32) * HGRN_WIDTH ** -0.5
    w_out = nrm(ks[17], (DEPTH, D_MODEL, D_MODEL), f32) * D_MODEL ** -0.5
    final_norm_w = 1.0 + 0.01 * nrm(ks[18], (D_MODEL,), f32)
    return {'x': x, 'norm_w': norm_w, 'w_in': w_in,
            'ssm_lambda_re': ssm_lambda_re, 'ssm_lambda_im': ssm_lambda_im,
            'ssm_b_re': ssm_b_re, 'ssm_b_im': ssm_b_im,
            'ssm_c_re': ssm_c_re, 'ssm_c_im': ssm_c_im,
            'ssm_d': ssm_d, 'ssm_log_dt': ssm_log_dt,
            'ssm_w_glu': ssm_w_glu, 'ssm_b_glu': ssm_b_glu,
            'hgrn_lb_logits': hgrn_lb_logits, 'hgrn_norm_w': hgrn_norm_w,
            'w_proj_a': w_proj_a, 'w_proj_b': w_proj_b, 'w_out': w_out,
            'final_norm_w': final_norm_w}


def reference(x, norm_w, w_in, ssm_lambda_re, ssm_lambda_im, ssm_b_re, ssm_b_im,
              ssm_c_re, ssm_c_im, ssm_d, ssm_log_dt, ssm_w_glu, ssm_b_glu,
              hgrn_lb_logits, hgrn_norm_w, w_proj_a, w_proj_b, w_out, final_norm_w):
    lower_bounds = jnp.cumsum(jax.nn.softmax(hgrn_lb_logits.astype(jnp.float32), axis=0), axis=0)
    h = x
    for layer in range(DEPTH):
        xn = rms_norm(h, norm_w[layer])
        proj = xn @ w_in[layer]
        u_a, z_a, q_b, f_b, i_b, og_b, z_b, g_a, g_b = jnp.split(proj, SPLIT_POINTS, axis=-1)
        y_a = s5_branch(u_a, z_a, ssm_lambda_re[layer], ssm_lambda_im[layer],
                        ssm_b_re[layer], ssm_b_im[layer], ssm_c_re[layer], ssm_c_im[layer],
                        ssm_d[layer], ssm_log_dt[layer], ssm_w_glu[layer], ssm_b_glu[layer])
        y_b = hgrn2_branch(q_b, f_b, i_b, og_b, z_b, lower_bounds[layer], hgrn_norm_w[layer])
        merged = (jax.nn.sigmoid(g_a.astype(jnp.float32)) * (y_a @ w_proj_a[layer])
                  + jax.nn.sigmoid(g_b.astype(jnp.float32)) * (y_b @ w_proj_b[layer]))
        h = h + (merged @ w_out[layer]).astype(h.dtype)
    return rms_norm(h, final_norm_w)
```

```cpp
#include <hip/hip_runtime.h>
#include <hip/hip_cooperative_groups.h>
#include <cstdio>
#include <cstdint>
namespace cg = cooperative_groups;

#ifndef DBG_CHECK
#define DBG_CHECK 0
#endif
#ifndef PHASES
#define PHASES 0x1ff
#endif
#define PH(k) (((PHASES) >> (k)) & 1)

#define LAS __attribute__((address_space(3)))
typedef unsigned short bf16_t;
typedef short bf16x8 __attribute__((ext_vector_type(8)));
typedef float f32x4 __attribute__((ext_vector_type(4)));
typedef unsigned u32x4 __attribute__((ext_vector_type(4)));
typedef unsigned u32x2 __attribute__((ext_vector_type(2)));

constexpr int SEQ = 8192, DM = 1024, MTOK = 16384;
constexpr int INW = 5632, NATW = 5120;
constexpr float NORM_EPS = 1e-6f;
constexpr int NC_ZA = 0, NC_Q = 512, NC_F = 1024, NC_I = 1536, NC_OG = 2048, NC_ZB = 2560, NC_GA = 3072, NC_GB = 4096;

constexpr size_t MiB = 1u << 20;
constexpr size_t WS_CTL = 0;
constexpr size_t WS_WIN = 1 * MiB, WS_WGLU = 12 * MiB, WS_WPA = 13 * MiB, WS_WPB = 14 * MiB, WS_WOUT = 15 * MiB;
constexpr size_t WS_TQ = 17 * MiB, WS_PP = 23 * MiB, WS_MISC = 27 * MiB, WS_ROWSS = 28 * MiB;
constexpr size_t WS_AS5 = 29 * MiB, WS_YG = 53 * MiB, WS_YB = 69 * MiB, WS_NAT = 85 * MiB, WS_END = 245 * MiB;
constexpr size_t DO_XN = 0, DO_US = 0, DO_HLOC = 32 * MiB, DO_DEC = 48 * MiB;

__device__ __forceinline__ float bf2f(bf16_t h) { return __uint_as_float(((unsigned)h) << 16); }
__device__ __forceinline__ unsigned f2bf(float f) { unsigned u = __float_as_uint(f); return (u + 0x7fffu + ((u >> 16) & 1u)) >> 16; }
__device__ __forceinline__ unsigned pk2(float lo, float hi) { return f2bf(lo) | (f2bf(hi) << 16); }
__device__ __forceinline__ float bflo(unsigned w) { return __uint_as_float(w << 16); }
__device__ __forceinline__ float bfhi(unsigned w) { return __uint_as_float(w & 0xffff0000u); }
__device__ __forceinline__ float sigmoidf_(float x) { return __builtin_amdgcn_rcpf(1.f + __expf(-x)); }
__device__ __forceinline__ float siluf_(float x) { return x * sigmoidf_(x); }
__device__ __forceinline__ float gelu_tanh(float x) { const float u = 0.7978845608028654f * (x + 0.044715f * x * x * x); return x * sigmoidf_(2.f * u); }
__device__ __forceinline__ float wave_sum(float v) {
#pragma unroll
    for (int o = 1; o < 64; o <<= 1) v += __shfl_xor(v, o);
    return v;
}
#define LDS_WAIT() asm volatile("s_waitcnt lgkmcnt(0)" ::: "memory")
__device__ __forceinline__ int opaque_tid() { int t = threadIdx.x; asm volatile("" : "+v"(t)); return t; }

struct Args { const float* in[19]; float* out; unsigned char* ws; };

namespace pg8 {
constexpr int BM = 256, BK = 64, HALF = 128, HTB = HALF * BK * 2, STAGE_BYTES = 8 * HTB, NXCD = 8, WGM = 8;
__host__ __device__ __forceinline__ int lds_byte(int r, int c) { const int st = (r >> 4) * 2 + (c >> 5), rr = r & 15, cc = c & 31, ob = rr * 64 + cc * 2; return st * 1024 + (ob ^ (((ob >> 9) & 1) << 5)); }
__host__ __device__ __forceinline__ void stage_rc(int b, int& R, int& C) { const int st = b / 1024, sb = b % 1024, swz = sb ^ (((sb >> 9) & 1) << 5); R = (st >> 1) * 16 + swz / 64; C = (st & 1) * 32 + (swz % 64) / 2; }
__host__ __device__ __forceinline__ int perm32(int rho) { const int n = rho >> 4, i = rho & 15; return 8 * (i >> 2) + 4 * n + (i & 3); }

struct Unit { int pm, pn; };
struct Gemm { const bf16_t* A; const bf16_t* Bt; int lda, ldb, K; };

struct StaticOrder {
    int nM, nN, nwg, G, c;
    __device__ void init(int M, int N, int G_, int c_) { nM = M / BM; nN = N / BM; nwg = nM * nN; G = G_; c = c_; }
    __device__ bool next(int i, Unit& u) const {
        const long L = (long)i * G + c; if (L >= nwg) return false;
        int wgid = (int)L; { const int q = nwg / NXCD, r = nwg % NXCD, xcd = wgid % NXCD, off = wgid / NXCD; wgid = (xcd < r ? xcd * (q + 1) : r * (q + 1) + (xcd - r) * q) + off; }
        const int nig = WGM * nN, gid = wgid / nig, fm = gid * WGM, gsz = (nM - fm) < WGM ? (nM - fm) : WGM;
        u.pm = fm + ((wgid % nig) % gsz); u.pn = (wgid % nig) / gsz; return true;
    }
};
struct S5Order {
    int G, c;
    __device__ bool next(int i, Unit& u) const { const int L = i * G + c; if (L >= 128) return false; u.pm = L; u.pn = L >> 2; return true; }
};

__device__ __forceinline__ unsigned cvt_pk_bf16(float lo, float hi) { unsigned r; asm volatile("v_cvt_pk_bf16_f32 %0, %1, %2" : "=v"(r) : "v"(lo), "v"(hi)); return r; }

#define EPI_LOOP_BEGIN  _Pragma("unroll") for (int ai = 0; ai < 2; ++ai) _Pragma("unroll") for (int m = 0; m < 4; ++m) { const int row = u.pm * BM + ai * HALF + wr * 64 + m * 16 + fr; _Pragma("unroll") for (int bj = 0; bj < 2; ++bj) { const int lc = bj * HALF + wc * 32 + 8 * fq; const f32x4 v0 = acc[ai][bj][m][0], v1 = acc[ai][bj][m][1];
#define EPI_LOOP_END } }

struct EpiG1 {
    static constexpr bool PERM = true;
    bf16_t* as5; bf16_t* nat;
    __device__ __forceinline__ void operator()(const f32x4 (&acc)[2][2][4][2], const Unit& u, int wr, int wc, int fr, int fq) const {
        EPI_LOOP_BEGIN
            u32x4 w; w.x = cvt_pk_bf16(v0[0], v0[1]); w.y = cvt_pk_bf16(v0[2], v0[3]); w.z = cvt_pk_bf16(v1[0], v1[1]); w.w = cvt_pk_bf16(v1[2], v1[3]);
            if (u.pn < 2) {
                const int col = u.pn * BM + lc, g = col >> 4, p0 = col & 15, chunk = row >> 4, s = row & 15;
                *(u32x4*)(as5 + ((size_t)(g * 1024 + chunk)) * 384 + s * 16 + p0) = w;
            } else {
                *(u32x4*)(nat + (size_t)row * NATW + (u.pn * BM - 512 + lc)) = w;
            }
        EPI_LOOP_END
    }
};
struct EpiHloc {
    static constexpr bool PERM = true;
    float* hloc;
    __device__ __forceinline__ void operator()(const f32x4 (&acc)[2][2][4][2], const Unit& u, int wr, int wc, int fr, int fq) const {
        EPI_LOOP_BEGIN
            if (bj == 0) { float* p = hloc + (size_t)row * 128 + lc; *(f32x4*)p = v0; *(f32x4*)(p + 4) = v1; }
        EPI_LOOP_END
    }
};
struct EpiYg {
    static constexpr bool PERM = true;
    bf16_t* yg;
    __device__ __forceinline__ void operator()(const f32x4 (&acc)[2][2][4][2], const Unit& u, int wr, int wc, int fr, int fq) const {
        const int g = u.pn;
        EPI_LOOP_BEGIN
            const int chunk = row - g * 1024, j = lc >> 4, p0 = lc & 15;
            u32x4 w; w.x = cvt_pk_bf16(gelu_tanh(v0[0]), gelu_tanh(v0[1])); w.y = cvt_pk_bf16(gelu_tanh(v0[2]), gelu_tanh(v0[3]));
            w.z = cvt_pk_bf16(gelu_tanh(v1[0]), gelu_tanh(v1[1])); w.w = cvt_pk_bf16(gelu_tanh(v1[2]), gelu_tanh(v1[3]));
            *(u32x4*)(yg + ((size_t)(chunk * 16 + j)) * 512 + g * 16 + p0) = w;
        EPI_LOOP_END
    }
};
struct EpiGlu {
    static constexpr bool PERM = true;
    const bf16_t* yg; const bf16_t* nat; const float* bias; bf16_t* ya;
    __device__ __forceinline__ void operator()(const f32x4 (&acc)[2][2][4][2], const Unit& u, int wr, int wc, int fr, int fq) const {
        EPI_LOOP_BEGIN
            const int col = u.pn * BM + lc;
            const f32x4 b0 = *(const f32x4*)(bias + col), b1 = *(const f32x4*)(bias + col + 4);
            const u32x4 y = *(const u32x4*)(yg + (size_t)row * 512 + col), z = *(const u32x4*)(nat + (size_t)row * NATW + NC_ZA + col);
            float o[8];
            o[0] = bflo(y.x) * sigmoidf_(v0[0] + b0[0]) * siluf_(bflo(z.x)); o[1] = bfhi(y.x) * sigmoidf_(v0[1] + b0[1]) * siluf_(bfhi(z.x));
            o[2] = bflo(y.y) * sigmoidf_(v0[2] + b0[2]) * siluf_(bflo(z.y)); o[3] = bfhi(y.y) * sigmoidf_(v0[3] + b0[3]) * siluf_(bfhi(z.y));
            o[4] = bflo(y.z) * sigmoidf_(v1[0] + b1[0]) * siluf_(bflo(z.z)); o[5] = bfhi(y.z) * sigmoidf_(v1[1] + b1[1]) * siluf_(bfhi(z.z));
            o[6] = bflo(y.w) * sigmoidf_(v1[2] + b1[2]) * siluf_(bflo(z.w)); o[7] = bfhi(y.w) * sigmoidf_(v1[3] + b1[3]) * siluf_(bfhi(z.w));
            u32x4 w; w.x = cvt_pk_bf16(o[0], o[1]); w.y = cvt_pk_bf16(o[2], o[3]); w.z = cvt_pk_bf16(o[4], o[5]); w.w = cvt_pk_bf16(o[6], o[7]);
            *(u32x4*)(ya + (size_t)row * 512 + col) = w;
        EPI_LOOP_END
    }
};
struct EpiM1 {
    static constexpr bool PERM = true;
    const bf16_t* nat; float* tmp;
    __device__ __forceinline__ void operator()(const f32x4 (&acc)[2][2][4][2], const Unit& u, int wr, int wc, int fr, int fq) const {
        EPI_LOOP_BEGIN
            const int col = u.pn * BM + lc;
            const u32x4 gq = *(const u32x4*)(nat + (size_t)row * NATW + NC_GA + col);
            f32x4 o0, o1;
            o0[0] = sigmoidf_(bflo(gq.x)) * v0[0]; o0[1] = sigmoidf_(bfhi(gq.x)) * v0[1]; o0[2] = sigmoidf_(bflo(gq.y)) * v0[2]; o0[3] = sigmoidf_(bfhi(gq.y)) * v0[3];
            o1[0] = sigmoidf_(bflo(gq.z)) * v1[0]; o1[1] = sigmoidf_(bfhi(gq.z)) * v1[1]; o1[2] = sigmoidf_(bflo(gq.w)) * v1[2]; o1[3] = sigmoidf_(bfhi(gq.w)) * v1[3];
            float* p = tmp + (size_t)row * DM + col; *(f32x4*)p = o0; *(f32x4*)(p + 4) = o1;
        EPI_LOOP_END
    }
};
struct EpiM2 {
    static constexpr bool PERM = true;
    bf16_t* nat; const float* tmp;
    __device__ __forceinline__ void operator()(const f32x4 (&acc)[2][2][4][2], const Unit& u, int wr, int wc, int fr, int fq) const {
        EPI_LOOP_BEGIN
            const int col = u.pn * BM + lc;
            bf16_t* gp = nat + (size_t)row * NATW + NC_GB + col;
            const u32x4 gq = *(const u32x4*)gp;
            const float* p = tmp + (size_t)row * DM + col; const f32x4 t0 = *(const f32x4*)p, t1 = *(const f32x4*)(p + 4);
            float o[8];
            o[0] = t0[0] + sigmoidf_(bflo(gq.x)) * v0[0]; o[1] = t0[1] + sigmoidf_(bfhi(gq.x)) * v0[1]; o[2] = t0[2] + sigmoidf_(bflo(gq.y)) * v0[2]; o[3] = t0[3] + sigmoidf_(bfhi(gq.y)) * v0[3];
            o[4] = t1[0] + sigmoidf_(bflo(gq.z)) * v1[0]; o[5] = t1[1] + sigmoidf_(bfhi(gq.z)) * v1[1]; o[6] = t1[2] + sigmoidf_(bflo(gq.w)) * v1[2]; o[7] = t1[3] + sigmoidf_(bfhi(gq.w)) * v1[3];
            u32x4 w; w.x = cvt_pk_bf16(o[0], o[1]); w.y = cvt_pk_bf16(o[2], o[3]); w.z = cvt_pk_bf16(o[4], o[5]); w.w = cvt_pk_bf16(o[6], o[7]);
            *(u32x4*)gp = w;
        EPI_LOOP_END
    }
};
struct EpiOut {
    static constexpr bool PERM = true;
    const float* x; float* out; float* rowss;
    __device__ __forceinline__ void operator()(const f32x4 (&acc)[2][2][4][2], const Unit& u, int wr, int wc, int fr, int fq) const {
#pragma unroll
        for (int ai = 0; ai < 2; ++ai)
#pragma unroll
            for (int m = 0; m < 4; ++m) {
                const int row = u.pm * BM + ai * HALF + wr * 64 + m * 16 + fr; float ss = 0.f;
#pragma unroll
                for (int bj = 0; bj < 2; ++bj) {
                    const int col = u.pn * BM + bj * HALF + wc * 32 + 8 * fq;
                    const float* xp = x + (size_t)row * DM + col; float* op = out + (size_t)row * DM + col;
                    const f32x4 h0 = *(const f32x4*)xp + acc[ai][bj][m][0], h1 = *(const f32x4*)(xp + 4) + acc[ai][bj][m][1];
                    *(f32x4*)op = h0; *(f32x4*)(op + 4) = h1;
                    ss += (h0[0] * h0[0] + h0[1] * h0[1]) + (h0[2] * h0[2] + h0[3] * h0[3]) + (h1[0] * h1[0] + h1[1] * h1[1]) + (h1[2] * h1[2] + h1[3] * h1[3]);
                }
                ss += __shfl_xor(ss, 16); ss += __shfl_xor(ss, 32);
                if (fq == 0) rowss[(size_t)row * 16 + u.pn * 4 + wc] = ss;
            }
    }
};

template <class Epi, class Sched, bool ALIGN_EPI = true, bool SP2 = true>
__device__ __forceinline__ void gemm_phase(LAS unsigned char* lds, const Gemm g, const Sched& S, const Epi& E) {
    const int tid = opaque_tid(), wid = __builtin_amdgcn_readfirstlane(tid >> 6), lane = tid & 63, wr = wid >> 2, wc = wid & 3, fr = lane & 15, fq = lane >> 4;
    const int K = g.K, nt = K / BK;
    unsigned voffA[2], voffB[2];
#pragma unroll
    for (int i = 0; i < 2; ++i) { int R, C; stage_rc(tid * 16 + i * 8192, R, C); const int Rb = Epi::PERM ? ((R & ~31) + perm32(R & 31)) : R;
        voffA[i] = (unsigned)(R * g.lda + C) * 2u; voffB[i] = (unsigned)(Rb * g.ldb + C) * 2u; }
    const size_t kstep = (size_t)(BK * 2);
    const size_t hstepA = (size_t)HALF * g.lda * 2, hstepB = (size_t)HALF * g.ldb * 2;
    const size_t tstepA = 2 * hstepA, tstepB = 2 * hstepB;
    const unsigned ldsw = (unsigned)wid * 1024u;
    const int aoff = lds_byte(wr * 64 + fr, fq * 8), boff = lds_byte(wc * 32 + fr, fq * 8);
#define PG8_SA(b, h) (((b) * 2 + (h)) * HTB)
#define PG8_SB(b, h) ((4 + (b) * 2 + (h)) * HTB)
#define PG8_STAGE(bufoff, gbase, voff) do { _Pragma("unroll") for (int _i = 0; _i < 2; ++_i) \
        __builtin_amdgcn_global_load_lds((const unsigned*)((const char*)(gbase) + (voff)[_i]), (LAS unsigned*)(lds + (bufoff) + ldsw + _i * 8192), 16, 0, 0); } while (0)
#define PG8_LDA(dst, b, h) do { _Pragma("unroll") for (int m = 0; m < 4; ++m) _Pragma("unroll") for (int k = 0; k < 2; ++k) dst[m][k] = *(const LAS bf16x8*)(lds + PG8_SA(b, h) + aoff + m * 2048 + k * 1024); } while (0)
#define PG8_LDB(dst, b, h) do { _Pragma("unroll") for (int n = 0; n < 2; ++n) _Pragma("unroll") for (int k = 0; k < 2; ++k) dst[n][k] = *(const LAS bf16x8*)(lds + PG8_SB(b, h) + boff + n * 2048 + k * 1024); } while (0)
#define PG8_MMA(ai, bj, At, Bt) do { __builtin_amdgcn_s_setprio(1); _Pragma("unroll") for (int m = 0; m < 4; ++m) _Pragma("unroll") for (int n = 0; n < 2; ++n) _Pragma("unroll") for (int k = 0; k < 2; ++k) \
        acc[ai][bj][m][n] = __builtin_amdgcn_mfma_f32_16x16x32_bf16(Bt[n][k], At[m][k], acc[ai][bj][m][n], 0, 0, 0); __builtin_amdgcn_s_setprio(0); } while (0)
#define PG8_WAIT_V(n) asm volatile("s_waitcnt vmcnt(" #n ")" ::: "memory")
#define PG8_WAIT_L(n) asm volatile("s_waitcnt lgkmcnt(" #n ")" ::: "memory")
#define PG8_BAR __builtin_amdgcn_s_barrier()
#define PG8_SCHED __builtin_amdgcn_sched_barrier(0)
    Unit cur, nxt; int ui = 0;
    if (!S.next(0, cur)) return;
    f32x4 acc[2][2][4][2];
#pragma unroll
    for (int a = 0; a < 2; ++a)
#pragma unroll
        for (int b = 0; b < 2; ++b)
#pragma unroll
            for (int m = 0; m < 4; ++m)
#pragma unroll
                for (int n = 0; n < 2; ++n) acc[a][b][m][n] = (f32x4){0.f, 0.f, 0.f, 0.f};
    bf16x8 At[4][2], B0[2][2], B1[2][2];
    const char* cA = (const char*)g.A + (size_t)cur.pm * tstepA; const char* cB = (const char*)g.Bt + (size_t)cur.pn * tstepB;
    if constexpr (SP2) {
        PG8_STAGE(PG8_SB(0, 0), cB, voffB); PG8_STAGE(PG8_SB(0, 1), cB + hstepB, voffB); PG8_STAGE(PG8_SA(0, 0), cA, voffA); PG8_STAGE(PG8_SA(0, 1), cA + hstepA, voffA);
        if (wr == 1) PG8_BAR;
        PG8_WAIT_V(2); PG8_BAR;
        PG8_STAGE(PG8_SB(1, 0), cB + kstep, voffB); PG8_STAGE(PG8_SA(1, 0), cA + kstep, voffA); PG8_STAGE(PG8_SB(1, 1), cB + hstepB + kstep, voffB);
        PG8_WAIT_V(6); PG8_BAR;
    } else {
        PG8_STAGE(PG8_SB(0, 0), cB, voffB); PG8_STAGE(PG8_SA(0, 0), cA, voffA); PG8_STAGE(PG8_SB(0, 1), cB + hstepB, voffB); PG8_STAGE(PG8_SA(0, 1), cA + hstepA, voffA);
        if (wr == 1) PG8_BAR;
        PG8_WAIT_V(4); PG8_BAR;
        PG8_STAGE(PG8_SB(1, 0), cB + kstep, voffB); PG8_STAGE(PG8_SA(1, 0), cA + kstep, voffA); PG8_STAGE(PG8_SB(1, 1), cB + hstepB + kstep, voffB);
        PG8_WAIT_V(6); PG8_BAR;
    }
    for (;;) {
        const bool has_next = S.next(ui + 1, nxt);
        const char* nA = has_next ? (const char*)g.A + (size_t)nxt.pm * tstepA : cA; const char* nB = has_next ? (const char*)g.Bt + (size_t)nxt.pn * tstepB : cB;
        for (int t = 0; t < nt; t += 2) {
            const bool last = (t == nt - 2);
            const char* a1 = cA + (size_t)(t + 1) * kstep;
            const char* a2 = last ? nA : cA + (size_t)(t + 2) * kstep; const char* b2 = last ? nB : cB + (size_t)(t + 2) * kstep;
            const char* a3 = a2 + kstep; const char* b3 = b2 + kstep;
            if constexpr (SP2) {
            PG8_LDB(B0, 0, 0); PG8_LDB(B1, 0, 1); PG8_SCHED; PG8_LDA(At, 0, 0); PG8_STAGE(PG8_SA(1, 1), a1 + hstepA, voffA);
            PG8_WAIT_V(8); PG8_WAIT_L(0); PG8_BAR; PG8_MMA(0, 0, At, B0); PG8_MMA(0, 1, At, B1); PG8_BAR; PG8_SCHED;
            PG8_LDA(At, 0, 1); PG8_STAGE(PG8_SB(0, 0), b2, voffB); PG8_STAGE(PG8_SB(0, 1), b2 + hstepB, voffB); PG8_STAGE(PG8_SA(0, 0), a2, voffA);
            PG8_WAIT_V(8); PG8_WAIT_L(0); PG8_BAR; PG8_MMA(1, 0, At, B0); PG8_MMA(1, 1, At, B1); PG8_BAR; PG8_SCHED;
            PG8_LDB(B0, 1, 0); PG8_LDB(B1, 1, 1); PG8_SCHED; PG8_LDA(At, 1, 0); PG8_STAGE(PG8_SA(0, 1), a2 + hstepA, voffA);
            PG8_WAIT_V(8); PG8_WAIT_L(0); PG8_BAR; PG8_MMA(0, 0, At, B0); PG8_MMA(0, 1, At, B1); PG8_BAR; PG8_SCHED;
            PG8_LDA(At, 1, 1); PG8_STAGE(PG8_SB(1, 0), b3, voffB); PG8_STAGE(PG8_SB(1, 1), b3 + hstepB, voffB); PG8_STAGE(PG8_SA(1, 0), a3, voffA);
            PG8_WAIT_V(8); PG8_WAIT_L(0); PG8_BAR; PG8_MMA(1, 0, At, B0); PG8_MMA(1, 1, At, B1); PG8_BAR; PG8_SCHED;
            } else {
            PG8_LDB(B0, 0, 0); PG8_SCHED; PG8_LDA(At, 0, 0); PG8_STAGE(PG8_SA(1, 1), a1 + hstepA, voffA);
            PG8_WAIT_L(8); PG8_BAR; PG8_WAIT_L(0); PG8_MMA(0, 0, At, B0); PG8_BAR; PG8_SCHED;
            PG8_LDB(B1, 0, 1); PG8_STAGE(PG8_SB(0, 0), b2, voffB);
            PG8_BAR; PG8_WAIT_L(0); PG8_MMA(0, 1, At, B1); PG8_BAR;
            PG8_LDA(At, 0, 1); PG8_STAGE(PG8_SA(0, 0), a2, voffA);
            PG8_BAR; PG8_WAIT_L(0); PG8_MMA(1, 0, At, B0); PG8_BAR; PG8_SCHED;
            PG8_STAGE(PG8_SB(0, 1), b2 + hstepB, voffB);
            PG8_WAIT_V(6); PG8_BAR; PG8_MMA(1, 1, At, B1); PG8_BAR;
            PG8_LDB(B0, 1, 0); PG8_SCHED; PG8_LDA(At, 1, 0); PG8_STAGE(PG8_SA(0, 1), a2 + hstepA, voffA);
            PG8_WAIT_L(8); PG8_BAR; PG8_WAIT_L(0); PG8_MMA(0, 0, At, B0); PG8_BAR; PG8_SCHED;
            PG8_LDB(B1, 1, 1); PG8_STAGE(PG8_SB(1, 0), b3, voffB);
            PG8_BAR; PG8_WAIT_L(0); PG8_MMA(0, 1, At, B1); PG8_BAR;
            PG8_LDA(At, 1, 1); PG8_STAGE(PG8_SA(1, 0), a3, voffA);
            PG8_BAR; PG8_WAIT_L(0); PG8_MMA(1, 0, At, B0); PG8_BAR; PG8_SCHED;
            PG8_STAGE(PG8_SB(1, 1), b3 + hstepB, voffB);
            PG8_WAIT_V(6); PG8_BAR; PG8_MMA(1, 1, At, B1); PG8_BAR;
            }
        }
        if constexpr (ALIGN_EPI) { if (wr == 0) PG8_BAR; }
        E(acc, cur, wr, wc, fr, fq);
        if (!has_next) break;
#pragma unroll
        for (int a = 0; a < 2; ++a)
#pragma unroll
            for (int b = 0; b < 2; ++b)
#pragma unroll
                for (int m = 0; m < 4; ++m)
#pragma unroll
                    for (int n = 0; n < 2; ++n) acc[a][b][m][n] = (f32x4){0.f, 0.f, 0.f, 0.f};
        cur = nxt; cA = nA; cB = nB; ++ui;
        if constexpr (ALIGN_EPI) { if (wr == 1) PG8_BAR; }
    }
    PG8_WAIT_V(0);
    if constexpr (!ALIGN_EPI) { if (wr == 0) PG8_BAR; }
    PG8_BAR;
#undef PG8_SA
#undef PG8_SB
#undef PG8_STAGE
#undef PG8_LDA
#undef PG8_LDB
#undef PG8_MMA
#undef PG8_WAIT_V
#undef PG8_WAIT_L
#undef PG8_BAR
#undef PG8_SCHED
}
}

__device__ __forceinline__ void p0_transpose_item(const float* W, int K, int N, bf16_t* WT, const float* scale, LAS float* scr, int item, int lane) {
    const int nblk = N / 32, kb = item / nblk, nb = item % nblk, k0 = 64 * kb, n0 = 32 * nb;
#pragma unroll 8
    for (int i = 0; i < 32; ++i) { const int kk = 2 * i + (lane >> 5); float v = W[(size_t)(k0 + kk) * N + n0 + (lane & 31)]; if (scale) v *= scale[k0 + kk]; scr[kk * 33 + (lane & 31)] = v; }
    LDS_WAIT(); asm volatile("" ::: "memory");
    const int c = lane & 7;
#pragma unroll
    for (int j = 0; j < 4; ++j) { const int n = (lane >> 3) + 8 * j; const LAS float* s = scr + (8 * c) * 33 + n;
        u32x4 o; o.x = pk2(s[0 * 33], s[1 * 33]); o.y = pk2(s[2 * 33], s[3 * 33]); o.z = pk2(s[4 * 33], s[5 * 33]); o.w = pk2(s[6 * 33], s[7 * 33]);
        *(u32x4*)(WT + (size_t)(n0 + n) * K + k0 + 8 * c) = o; }
    LDS_WAIT(); asm volatile("" ::: "memory");
}

__device__ __forceinline__ void sincos_d(double x, double& s, double& c) {
    const double k = rint(x * 0.6366197723675814);
    double r = fma(-k, 1.5707963267948966, x); r = fma(-k, 6.123233995736766e-17, r);
    const double r2 = r * r;
    double ps = 1.0 / 6227020800.0; ps = fma(ps, r2, -1.0 / 39916800.0); ps = fma(ps, r2, 1.0 / 362880.0); ps = fma(ps, r2, -1.0 / 5040.0); ps = fma(ps, r2, 1.0 / 120.0); ps = fma(ps, r2, -1.0 / 6.0); ps = fma(ps, r2, 1.0);
    const double sr = r * ps;
    double pc = -1.0 / 87178291200.0; pc = fma(pc, r2, 1.0 / 479001600.0); pc = fma(pc, r2, -1.0 / 3628800.0); pc = fma(pc, r2, 1.0 / 40320.0); pc = fma(pc, r2, -1.0 / 720.0); pc = fma(pc, r2, 1.0 / 24.0); pc = fma(pc, r2, -0.5); pc = fma(pc, r2, 1.0);
    const int q = (int)(((long long)k) & 3);
    s = (q == 0) ? sr : (q == 1) ? pc : (q == 2) ? -sr : -pc;
    c = (q == 0) ? pc : (q == 1) ? -sr : (q == 2) ? -pc : sr;
}
__device__ __forceinline__ void s5_pow(double lr, double li, double dt, double tau, double& re, double& im) {
    const double mag = exp(lr * dt * tau); double s, c; sincos_d(li * dt * tau, s, c); re = mag * c; im = mag * s;
}

__device__ __forceinline__ void s5_build(const Args& a, int g, LAS unsigned char* lds, int tid_, bf16_t* TQ, bf16_t* PP, float* misc) {
    const int tid = opaque_tid();
    LAS float* pwr = (LAS float*)lds;
    LAS float* pwi = pwr + 17 * 64;
    LAS float* bbr = pwi + 17 * 64;
    LAS float* bbi = bbr + 1024;
    LAS float* cre = bbi + 1024;
    LAS float* cim = cre + 1024;
    LAS float* Kt = cim + 1024;
    if (tid < 64) {
        const int n = tid;
        const double dt = exp((double)a.in[10][g]);
        const double lr = (double)fminf(a.in[3][g * 64 + n], -1e-4f), li = (double)a.in[4][g * 64 + n];
        double are = 1.0, aim = 0.0;
        for (int tau = 0; tau <= 16; ++tau) { double re, im; s5_pow(lr, li, dt, (double)tau, re, im); pwr[tau * 64 + n] = (float)re; pwi[tau * 64 + n] = (float)im; if (tau == 1) { are = re; aim = im; } }
        const double den = lr * lr + li * li, nr = are - 1.0;
        const double cr = (nr * lr + aim * li) / den, ci = (aim * lr - nr * li) / den;
        for (int p = 0; p < 16; ++p) { const double br = (double)a.in[5][(g * 64 + n) * 16 + p], bi = (double)a.in[6][(g * 64 + n) * 16 + p];
            bbr[n * 16 + p] = (float)(cr * br - ci * bi); bbi[n * 16 + p] = (float)(cr * bi + ci * br); }
        double r2, i2; s5_pow(lr, li, dt, 1024.0, r2, i2);
        float* mp = misc + (size_t)(g * 64 + n) * 4; mp[0] = pwr[16 * 64 + n]; mp[1] = pwi[16 * 64 + n]; mp[2] = (float)r2; mp[3] = (float)i2;
    }
    for (int e = tid; e < 1024; e += 512) { cre[e] = a.in[7][g * 1024 + e]; cim[e] = a.in[8][g * 1024 + e]; }
    __syncthreads();
    for (int e = tid; e < 4096; e += 512) {
        const int tau = e >> 8, p = (e >> 4) & 15, pp = e & 15; float s = 0.f;
        for (int n = 0; n < 64; ++n) { const float pr = pwr[tau * 64 + n], pi = pwi[tau * 64 + n], br = bbr[n * 16 + pp], bi = bbi[n * 16 + pp];
            const float wre = pr * br - pi * bi, wim = pr * bi + pi * br; s += cre[p * 64 + n] * wre - cim[p * 64 + n] * wim; }
        if (tau == 0 && p == pp) s += a.in[9][g * 16 + p];
        Kt[e] = s;
    }
    __syncthreads();
    for (int e = tid; e < 256 * 384; e += 512) {
        const int row = e / 384, col = e - row * 384, j = row >> 4, p = row & 15; float v;
        if (col < 256) { const int s = col >> 4, pp = col & 15; v = (s <= j) ? Kt[((j - s) * 16 + p) * 16 + pp] : 0.f; }
        else { const int nn = col - 256, n = nn & 63; const float ar = pwr[(j + 1) * 64 + n], ai = pwi[(j + 1) * 64 + n], cr = cre[p * 64 + n], ci = cim[p * 64 + n];
            v = (nn < 64) ? (cr * ar - ci * ai) : -(cr * ai + ci * ar); }
        TQ[(size_t)(g * 256 + row) * 384 + col] = (bf16_t)f2bf(v);
    }
    for (int e = tid; e < 256 * 256; e += 512) {
        const int row = e >> 8, col = e & 255; float v = 0.f;
        if (row < 128) { const int n = row & 63, s = col >> 4, pp = col & 15; const float pr = pwr[(15 - s) * 64 + n], pi = pwi[(15 - s) * 64 + n], br = bbr[n * 16 + pp], bi = bbi[n * 16 + pp];
            v = (row < 64) ? (pr * br - pi * bi) : (pr * bi + pi * br); }
        PP[(size_t)(g * 256 + row) * 256 + col] = (bf16_t)f2bf(v);
    }
    __syncthreads();
}

__device__ __forceinline__ float hgrn_lb(const float* lg, int w) { return 1.f / (1.f + expf(lg[512 + w] - lg[w])); }

__device__ __forceinline__ void hgrn_h1(const Args& a, LAS unsigned char* lds, int item, int tid_, const bf16_t* nat, bf16_t* Ut, float* dec) {
    const int tid = opaque_tid();
    const int bh = item >> 7, c = item & 127, b = bh >> 2, h = bh & 3;
    const size_t row0 = (size_t)b * SEQ + (size_t)c * 64;
    LAS float* G32 = (LAS float*)lds;
    LAS float* KEY = G32 + 8192;
    LAS bf16_t* KLT = (LAS bf16_t*)(lds + 65536);
    LAS bf16_t* VT = KLT + 128 * 72;
    const int k = tid & 127;
    const float lbv = hgrn_lb(a.in[13], h * 128 + k);
    for (int e = tid; e < 8192; e += 512) {
        const int t = e >> 7; const bf16_t* r = nat + (row0 + t) * NATW + h * 128 + k;
        const float f = bf2f(r[NC_F]);
        const float sg = 1.f / (1.f + expf(-f)), sn = 1.f / (1.f + expf(f));
        G32[e] = logf(lbv + (1.f - lbv) * sg);
        KEY[e] = (1.f - lbv) * sn;
        VT[k * 72 + t] = r[NC_I];
    }
    __syncthreads();
    if (tid < 128) { float cum = 0.f; for (int t = 0; t < 64; ++t) { cum += G32[t * 128 + tid]; G32[t * 128 + tid] = cum; } }
    __syncthreads();
    { const float last = G32[63 * 128 + k];
      for (int e = tid; e < 8192; e += 512) { const int t = e >> 7; KLT[k * 72 + t] = (bf16_t)f2bf(KEY[e] * expf(last - G32[e])); }
      if (tid < 128) dec[(size_t)item * 128 + tid] = expf(last); }
    __syncthreads();
    const int w = tid >> 6, lane = tid & 63, fr = lane & 15, fq = lane >> 4, k0 = 16 * w;
    const bf16x8 a0 = *(const LAS bf16x8*)(KLT + (k0 + fr) * 72 + fq * 8), a1 = *(const LAS bf16x8*)(KLT + (k0 + fr) * 72 + 32 + fq * 8);
#pragma unroll
    for (int vt = 0; vt < 8; ++vt) {
        const bf16x8 b0 = *(const LAS bf16x8*)(VT + (vt * 16 + fr) * 72 + fq * 8), b1 = *(const LAS bf16x8*)(VT + (vt * 16 + fr) * 72 + 32 + fq * 8);
        f32x4 acc = (f32x4){0.f, 0.f, 0.f, 0.f};
        acc = __builtin_amdgcn_mfma_f32_16x16x32_bf16(a0, b0, acc, 0, 0, 0);
        acc = __builtin_amdgcn_mfma_f32_16x16x32_bf16(a1, b1, acc, 0, 0, 0);
        u32x2 o; o.x = pk2(acc[0], acc[1]); o.y = pk2(acc[2], acc[3]);
        *(u32x2*)(Ut + (size_t)item * 16384 + (vt * 16 + fr) * 128 + k0 + 4 * fq) = o;
    }
    __syncthreads();
}

__device__ __forceinline__ void hgrn_h2(int e, bf16_t* Ut, const float* dec) {
    const int bh = e >> 13, rem = e & 8191, v = rem >> 6, k = (rem & 63) * 2;
    unsigned* up = (unsigned*)(Ut + (size_t)bh * 128 * 16384 + v * 128 + k);
    const float* dp = dec + (size_t)bh * 128 * 128 + k;
    float s0 = 0.f, s1 = 0.f;
    for (int c0 = 0; c0 < 128; c0 += 16) {
        unsigned uu[16]; float d0[16], d1[16];
#pragma unroll
        for (int i = 0; i < 16; ++i) { uu[i] = up[(size_t)(c0 + i) * 8192]; const float2 dd = *(const float2*)(dp + (size_t)(c0 + i) * 128); d0[i] = dd.x; d1[i] = dd.y; }
#pragma unroll
        for (int i = 0; i < 16; ++i) { up[(size_t)(c0 + i) * 8192] = pk2(s0, s1); s0 = d0[i] * s0 + bflo(uu[i]); s1 = d1[i] * s1 + bfhi(uu[i]); }
    }
}

__device__ __forceinline__ void hgrn_h3(const Args& a, LAS unsigned char* lds, int item, int tid_, const bf16_t* nat, const bf16_t* St, bf16_t* yb) {
    const int tid = opaque_tid();
    const int bh = item >> 7, c = item & 127, b = bh >> 2, h = bh & 3;
    const size_t row0 = (size_t)b * SEQ + (size_t)c * 64;
    LAS float* CUM = (LAS float*)lds;
    LAS bf16_t* QD = (LAS bf16_t*)(lds + 32768);
    LAS bf16_t* KD = QD + 64 * 136;
    LAS bf16_t* VT = KD + 64 * 136;
    LAS bf16_t* PS = VT + 128 * 72;
    LAS float* SS = (LAS float*)(lds + 32768 + 2 * 64 * 136 * 2 + 128 * 72 * 2 + 64 * 72 * 2);
    const int k = tid & 127;
    const float lbv = hgrn_lb(a.in[13], h * 128 + k);
    for (int e = tid; e < 8192; e += 512) {
        const int t = e >> 7; const bf16_t* r = nat + (row0 + t) * NATW + h * 128 + k;
        const float f = bf2f(r[NC_F]);
        CUM[e] = logf(lbv + (1.f - lbv) / (1.f + expf(-f)));
        VT[k * 72 + t] = r[NC_I];
    }
    __syncthreads();
    if (tid < 128) { float cum = 0.f; for (int t = 0; t < 64; ++t) { cum += CUM[t * 128 + tid]; CUM[t * 128 + tid] = cum; } }
    __syncthreads();
    for (int e = tid; e < 8192; e += 512) {
        const int t = e >> 7; const bf16_t* r = nat + (row0 + t) * NATW + h * 128 + k;
        const float f = bf2f(r[NC_F]), q = bf2f(r[NC_Q]), cum = CUM[e];
        const float key = (1.f - lbv) / (1.f + expf(f));
        QD[t * 136 + k] = (bf16_t)f2bf(q / (1.f + expf(-q)) * expf(cum));
        KD[t * 136 + k] = (bf16_t)f2bf(key * expf(-cum));
    }
    __syncthreads();
    const int w = tid >> 6, lane = tid & 63, fr = lane & 15, fq = lane >> 4;
    {
        const int tt = w >> 1;
        bf16x8 qa[4];
#pragma unroll
        for (int ks = 0; ks < 4; ++ks) qa[ks] = *(const LAS bf16x8*)(QD + (tt * 16 + fr) * 136 + ks * 32 + fq * 8);
#pragma unroll
        for (int si = 0; si < 2; ++si) {
            const int st = 2 * (w & 1) + si;
            f32x4 acc = (f32x4){0.f, 0.f, 0.f, 0.f};
            if (st <= tt) {
#pragma unroll
                for (int ks = 0; ks < 4; ++ks) { const bf16x8 kb = *(const LAS bf16x8*)(KD + (st * 16 + fr) * 136 + ks * 32 + fq * 8); acc = __builtin_amdgcn_mfma_f32_16x16x32_bf16(qa[ks], kb, acc, 0, 0, 0); }
            }
#pragma unroll
            for (int j = 0; j < 4; ++j) { const int t = tt * 16 + 4 * fq + j, s = st * 16 + fr; PS[t * 72 + s] = (bf16_t)f2bf((s <= t) ? acc[j] : 0.f); }
        }
    }
    __syncthreads();
    const int v0 = 16 * w;
    bf16x8 sb[4], vb[2];
#pragma unroll
    for (int ks = 0; ks < 4; ++ks) sb[ks] = *(const bf16x8*)(St + (size_t)item * 16384 + (v0 + fr) * 128 + ks * 32 + fq * 8);
#pragma unroll
    for (int ks = 0; ks < 2; ++ks) vb[ks] = *(const LAS bf16x8*)(VT + (v0 + fr) * 72 + ks * 32 + fq * 8);
    f32x4 o[4];
#pragma unroll
    for (int tt = 0; tt < 4; ++tt) {
        f32x4 acc = (f32x4){0.f, 0.f, 0.f, 0.f};
#pragma unroll
        for (int ks = 0; ks < 2; ++ks) { const bf16x8 pa = *(const LAS bf16x8*)(PS + (tt * 16 + fr) * 72 + ks * 32 + fq * 8); acc = __builtin_amdgcn_mfma_f32_16x16x32_bf16(pa, vb[ks], acc, 0, 0, 0); }
#pragma unroll
        for (int ks = 0; ks < 4; ++ks) { const bf16x8 qa = *(const LAS bf16x8*)(QD + (tt * 16 + fr) * 136 + ks * 32 + fq * 8); acc = __builtin_amdgcn_mfma_f32_16x16x32_bf16(qa, sb[ks], acc, 0, 0, 0); }
        o[tt] = acc;
    }
    const int vcol = h * 128 + v0 + fr;
#pragma unroll
    for (int tt = 0; tt < 4; ++tt)
#pragma unroll
        for (int j = 0; j < 4; ++j) {
            const int t = tt * 16 + 4 * fq + j;
            const float og = bf2f(nat[(row0 + t) * NATW + NC_OG + vcol]);
            const float val = o[tt][j] / (1.f + expf(-og)); o[tt][j] = val;
            float ss = val * val; ss += __shfl_xor(ss, 1); ss += __shfl_xor(ss, 2); ss += __shfl_xor(ss, 4); ss += __shfl_xor(ss, 8);
            if (fr == 0) SS[w * 64 + t] = ss;
        }
    __syncthreads();
    const float hw = a.in[14][vcol];
#pragma unroll
    for (int tt = 0; tt < 4; ++tt)
#pragma unroll
        for (int j = 0; j < 4; ++j) {
            const int t = tt * 16 + 4 * fq + j; float tot = 0.f;
#pragma unroll
            for (int ww = 0; ww < 8; ++ww) tot += SS[ww * 64 + t];
            const float rs = rsqrtf(tot * (1.f / 128.f) + NORM_EPS);
            const float zb = bf2f(nat[(row0 + t) * NATW + NC_ZB + vcol]);
            yb[(row0 + t) * 512 + vcol] = (bf16_t)f2bf(o[tt][j] * rs * hw * (zb / (1.f + expf(-zb))));
        }
    __syncthreads();
}

__device__ __forceinline__ void s5_carry(LAS unsigned char* lds, int item, int tid_, const float* hloc, bf16_t* as5, const float* misc) {
    const int tid = opaque_tid();
    const int b = item >> 5, g = item & 31, n = tid & 63, seg = tid >> 6;
    LAS float* E = (LAS float*)lds;
    const float* mp = misc + (size_t)(g * 64 + n) * 4;
    const float ar = mp[0], ai = mp[1], Ar = mp[2], Ai = mp[3];
    const size_t R0 = (size_t)g * 1024 + (size_t)b * 512 + (size_t)seg * 64;
    const float* hp = hloc + R0 * 128 + n;
    float hr = 0.f, hi = 0.f;
    for (int c0 = 0; c0 < 64; c0 += 16) {
        float lr[16], li[16];
#pragma unroll
        for (int i = 0; i < 16; ++i) { lr[i] = hp[(size_t)(c0 + i) * 128]; li[i] = hp[(size_t)(c0 + i) * 128 + 64]; }
#pragma unroll
        for (int i = 0; i < 16; ++i) { const float nr = ar * hr - ai * hi + lr[i], ni = ar * hi + ai * hr + li[i]; hr = nr; hi = ni; }
    }
    E[(seg * 64 + n) * 2] = hr; E[(seg * 64 + n) * 2 + 1] = hi;
    __syncthreads();
    hr = 0.f; hi = 0.f;
    for (int j = 0; j < seg; ++j) { const float er = E[(j * 64 + n) * 2], ei = E[(j * 64 + n) * 2 + 1]; const float nr = Ar * hr - Ai * hi + er, ni = Ar * hi + Ai * hr + ei; hr = nr; hi = ni; }
    bf16_t* op = as5 + R0 * 384 + 256 + n;
    for (int c0 = 0; c0 < 64; c0 += 16) {
        float lr[16], li[16];
#pragma unroll
        for (int i = 0; i < 16; ++i) { lr[i] = hp[(size_t)(c0 + i) * 128]; li[i] = hp[(size_t)(c0 + i) * 128 + 64]; }
#pragma unroll
        for (int i = 0; i < 16; ++i) { op[(size_t)(c0 + i) * 384] = (bf16_t)f2bf(hr); op[(size_t)(c0 + i) * 384 + 64] = (bf16_t)f2bf(hi);
            const float nr = ar * hr - ai * hi + lr[i], ni = ar * hi + ai * hr + li[i]; hr = nr; hi = ni; }
    }
    __syncthreads();
}

#if DBG_CHECK
__device__ __forceinline__ unsigned hash_u(unsigned x) { x ^= x >> 16; x *= 0x7feb352dU; x ^= x >> 15; x *= 0x846ca68bU; x ^= x >> 16; return x; }
__device__ __forceinline__ void chk_add(float* chk, int k, float opt, float ref, int lane) { if (lane == 0) { const float d = opt - ref; atomicAdd(chk + 2 * k, d * d); atomicAdd(chk + 2 * k + 1, ref * ref); } }
__device__ __forceinline__ float proj_ref(const Args& a, int t, int col, int lane) {
    const float* x = a.in[0] + (size_t)t * DM; float ss = 0.f;
    for (int j = lane; j < DM; j += 64) ss += x[j] * x[j];
    ss = wave_sum(ss); const float rstd = rsqrtf(ss * (1.f / DM) + NORM_EPS);
    float acc = 0.f;
    for (int j = lane; j < DM; j += 64) acc += x[j] * rstd * a.in[1][j] * a.in[2][(size_t)j * INW + col];
    return wave_sum(acc);
}
__device__ __forceinline__ void chk_proj(const Args& a, float* chk, int si, int lane, const bf16_t* as5, const bf16_t* nat) {
    const unsigned hsh = hash_u(si * 2 + 1); const int t = hsh % MTOK, col = (hsh >> 14) % INW;
    const float ref = proj_ref(a, t, col, lane); float opt;
    if (col < 512) { const int g = col >> 4, p = col & 15; opt = bf2f(as5[((size_t)(g * 1024 + (t >> 4))) * 384 + (t & 15) * 16 + p]); }
    else opt = bf2f(nat[(size_t)t * NATW + col - 512]);
    chk_add(chk, 1, opt, ref, lane);
}
__device__ __forceinline__ void chk_s5(const Args& a, float* chk, int si, int lane, const bf16_t* as5, const bf16_t* yg) {
    const unsigned hsh = hash_u(si * 2 + 77); const int b = hsh & 1, g = (hsh >> 1) & 31; int t = (hsh >> 6) % SEQ; if ((si & 3) == 0) t &= 63; if ((si & 3) == 1) t &= 1023;
    const int n = lane;
    const double dt = exp((double)a.in[10][g]);
    const double lr = (double)fminf(a.in[3][g * 64 + n], -1e-4f), li = (double)a.in[4][g * 64 + n];
    double are, aim; s5_pow(lr, li, dt, 1.0, are, aim);
    const double den = lr * lr + li * li, nr = are - 1.0;
    const double cr = (nr * lr + aim * li) / den, ci = (aim * lr - nr * li) / den;
    double bbr[16], bbi[16];
#pragma unroll
    for (int p = 0; p < 16; ++p) { const double br = (double)a.in[5][(g * 64 + n) * 16 + p], bi = (double)a.in[6][(g * 64 + n) * 16 + p]; bbr[p] = cr * br - ci * bi; bbi[p] = cr * bi + ci * br; }
    double hr = 0.0, hi = 0.0;
    for (int s = 0; s <= t; ++s) {
        const int tg = b * SEQ + s; const bf16_t* up = as5 + ((size_t)(g * 1024 + (tg >> 4))) * 384 + (tg & 15) * 16;
        const u32x4 w0 = *(const u32x4*)up, w1 = *(const u32x4*)(up + 8);
        float uf[16]; uf[0] = bflo(w0.x); uf[1] = bfhi(w0.x); uf[2] = bflo(w0.y); uf[3] = bfhi(w0.y); uf[4] = bflo(w0.z); uf[5] = bfhi(w0.z); uf[6] = bflo(w0.w); uf[7] = bfhi(w0.w);
        uf[8] = bflo(w1.x); uf[9] = bfhi(w1.x); uf[10] = bflo(w1.y); uf[11] = bfhi(w1.y); uf[12] = bflo(w1.z); uf[13] = bfhi(w1.z); uf[14] = bflo(w1.w); uf[15] = bfhi(w1.w);
        double br = 0.0, bi = 0.0;
#pragma unroll
        for (int p = 0; p < 16; ++p) { br += bbr[p] * (double)uf[p]; bi += bbi[p] * (double)uf[p]; }
        const double nhr = are * hr - aim * hi + br, nhi = are * hi + aim * hr + bi; hr = nhr; hi = nhi;
    }
    const int tg = b * SEQ + t;
    for (int p = 0; p < 16; ++p) {
        float y = (float)(hr * (double)a.in[7][(g * 16 + p) * 64 + n] - hi * (double)a.in[8][(g * 16 + p) * 64 + n]);
        y = wave_sum(y);
        y += a.in[9][g * 16 + p] * bf2f(as5[((size_t)(g * 1024 + (tg >> 4))) * 384 + (tg & 15) * 16 + p]);
        chk_add(chk, 2, bf2f(yg[(size_t)tg * 512 + g * 16 + p]), gelu_tanh(y), lane);
    }
}
__device__ __forceinline__ void chk_hgrn(const Args& a, float* chk, int si, int lane, const bf16_t* nat, const bf16_t* yb) {
    const unsigned hsh = hash_u(si * 2 + 1234567); const int b = hsh & 1, h = (hsh >> 1) & 3; int t = (hsh >> 4) % SEQ; if ((si & 3) == 0) t &= 255;
    const size_t rb = (size_t)b * SEQ;
    float q[2], D[2] = {1.f, 1.f}, o[2] = {0.f, 0.f}, lbv[2];
#pragma unroll
    for (int i = 0; i < 2; ++i) { const int k = lane + 64 * i; const float qq = bf2f(nat[(rb + t) * NATW + NC_Q + h * 128 + k]); q[i] = qq / (1.f + expf(-qq)); lbv[i] = hgrn_lb(a.in[13], h * 128 + k); }
    const int s_lo = t > 1023 ? t - 1023 : 0;
    for (int s = t; s >= s_lo; --s) {
        const bf16_t* r = nat + (rb + s) * NATW + h * 128; float w = 0.f, fg[2];
#pragma unroll
        for (int i = 0; i < 2; ++i) { const int k = lane + 64 * i; const float f = bf2f(r[NC_F + k]); fg[i] = lbv[i] + (1.f - lbv[i]) / (1.f + expf(-f)); w += q[i] * (1.f - fg[i]) * D[i]; }
        w = wave_sum(w);
#pragma unroll
        for (int i = 0; i < 2; ++i) { o[i] += w * bf2f(r[NC_I + lane + 64 * i]); D[i] *= fg[i]; }
    }
    float ss = 0.f;
#pragma unroll
    for (int i = 0; i < 2; ++i) { const float og = bf2f(nat[(rb + t) * NATW + NC_OG + h * 128 + lane + 64 * i]); o[i] = o[i] / (1.f + expf(-og)); ss += o[i] * o[i]; }
    ss = wave_sum(ss); const float rs = rsqrtf(ss * (1.f / 128.f) + NORM_EPS);
#pragma unroll
    for (int i = 0; i < 2; ++i) { const int vc = h * 128 + lane + 64 * i; const float zb = bf2f(nat[(rb + t) * NATW + NC_ZB + vc]); const float ref = o[i] * rs * a.in[14][vc] * (zb / (1.f + expf(-zb)));
        const float opt = bf2f(yb[(rb + t) * 512 + vc]); const float d = opt - ref; float n2 = wave_sum(d * d), r2 = wave_sum(ref * ref);
        if (lane == 0) { atomicAdd(chk + 6, n2); atomicAdd(chk + 7, r2); } }
}
__device__ __forceinline__ void chk_glu(const Args& a, float* chk, int si, int lane, const bf16_t* yg, const bf16_t* nat, const bf16_t* ya) {
    const unsigned hsh = hash_u(si * 2 + 999); const int t = hsh % MTOK, col = (hsh >> 14) & 511; float v = 0.f;
    for (int k = lane; k < 512; k += 64) v += bf2f(yg[(size_t)t * 512 + k]) * a.in[11][(size_t)k * 512 + col];
    v = wave_sum(v) + a.in[12][col];
    const float za = bf2f(nat[(size_t)t * NATW + NC_ZA + col]);
    const float ref = bf2f(yg[(size_t)t * 512 + col]) / (1.f + expf(-v)) * (za / (1.f + expf(-za)));
    chk_add(chk, 4, bf2f(ya[(size_t)t * 512 + col]), ref, lane);
}
__device__ __forceinline__ void chk_merge(const Args& a, float* chk, int si, int lane, const bf16_t* ya, const bf16_t* yb, const bf16_t* nat) {
    const unsigned hsh = hash_u(si * 2 + 31337); const int t = hsh % MTOK, n = (hsh >> 14) & 1023; float s1 = 0.f, s2 = 0.f;
    for (int k = lane; k < 512; k += 64) { s1 += bf2f(ya[(size_t)t * 512 + k]) * a.in[15][(size_t)k * DM + n]; s2 += bf2f(yb[(size_t)t * 512 + k]) * a.in[16][(size_t)k * DM + n]; }
    s1 = wave_sum(s1); s2 = wave_sum(s2);
    const float ga = bf2f(nat[(size_t)t * NATW + NC_GA + n]), gb = proj_ref(a, t, 512 + NC_GB + n, lane);
    const float ref = s1 / (1.f + expf(-ga)) + s2 / (1.f + expf(-gb));
    chk_add(chk, 5, bf2f(nat[(size_t)t * NATW + NC_GB + n]), ref, lane);
}
#endif

constexpr int LDS_BYTES = 147456;
__global__ void __launch_bounds__(512, 2) mega(Args a) {
    extern __shared__ __attribute__((aligned(16))) unsigned char lds_raw[];
    LAS unsigned char* lds = (LAS unsigned char*)lds_raw;
    cg::grid_group grid = cg::this_grid();
    const int tid = threadIdx.x, lane = tid & 63, wave = __builtin_amdgcn_readfirstlane(tid >> 6);
    const int G = gridDim.x, bx = blockIdx.x;
    const int gw = bx * 8 + wave, NGW = G * 8;
    unsigned char* ws = a.ws;
    float* chk = (float*)(ws + WS_CTL);
    bf16_t* Win_t = (bf16_t*)(ws + WS_WIN); bf16_t* Wglu_t = (bf16_t*)(ws + WS_WGLU); bf16_t* Wpa_t = (bf16_t*)(ws + WS_WPA); bf16_t* Wpb_t = (bf16_t*)(ws + WS_WPB); bf16_t* Wout_t = (bf16_t*)(ws + WS_WOUT);
    bf16_t* TQ = (bf16_t*)(ws + WS_TQ); bf16_t* PP = (bf16_t*)(ws + WS_PP); float* misc = (float*)(ws + WS_MISC); float* rowss = (float*)(ws + WS_ROWSS);
    bf16_t* as5 = (bf16_t*)(ws + WS_AS5); bf16_t* ya = (bf16_t*)(ws + WS_AS5); bf16_t* yg = (bf16_t*)(ws + WS_YG); bf16_t* yb = (bf16_t*)(ws + WS_YB); bf16_t* nat = (bf16_t*)(ws + WS_NAT);
    unsigned char* ob = (unsigned char*)a.out;
    bf16_t* xn = (bf16_t*)(ob + DO_XN); bf16_t* Ut = (bf16_t*)(ob + DO_US); float* hloc = (float*)(ob + DO_HLOC); float* dec = (float*)(ob + DO_DEC);

    if (PH(0)) {
        if (bx < 32) s5_build(a, bx, lds, tid, TQ, PP, misc);
        LAS float* scr = (LAS float*)(lds + wave * 16384);
        constexpr int I_IN = (DM / 64) * (INW / 32), I_GLU = (512 / 64) * (512 / 32), I_PA = (512 / 64) * (DM / 32), I_OUT = (DM / 64) * (DM / 32);
        constexpr int NITEMS = I_IN + I_GLU + 2 * I_PA + I_OUT;
        for (int it = gw; it < NITEMS; it += NGW) {
            int r = it;
            if (r < I_IN) { p0_transpose_item(a.in[2], DM, INW, Win_t, a.in[1], scr, r, lane); continue; } r -= I_IN;
            if (r < I_GLU) { p0_transpose_item(a.in[11], 512, 512, Wglu_t, nullptr, scr, r, lane); continue; } r -= I_GLU;
            if (r < I_PA) { p0_transpose_item(a.in[15], 512, DM, Wpa_t, nullptr, scr, r, lane); continue; } r -= I_PA;
            if (r < I_PA) { p0_transpose_item(a.in[16], 512, DM, Wpb_t, nullptr, scr, r, lane); continue; } r -= I_PA;
            p0_transpose_item(a.in[17], DM, DM, Wout_t, nullptr, scr, r, lane);
        }
        for (int m = gw; m < MTOK; m += NGW) {
            const f32x4* xr = (const f32x4*)(a.in[0] + (size_t)m * DM) + lane;
            f32x4 v[4]; float s = 0.f;
#pragma unroll
            for (int j = 0; j < 4; ++j) { v[j] = xr[64 * j]; s += (v[j].x * v[j].x + v[j].y * v[j].y) + (v[j].z * v[j].z + v[j].w * v[j].w); }
            const float rstd = rsqrtf(wave_sum(s) * (1.f / DM) + NORM_EPS);
            u32x2* o8 = (u32x2*)(xn + (size_t)m * DM) + lane;
#pragma unroll
            for (int j = 0; j < 4; ++j) { u32x2 o; o.x = pk2(v[j].x * rstd, v[j].y * rstd); o.y = pk2(v[j].z * rstd, v[j].w * rstd); o8[64 * j] = o; }
        }
    }
    grid.sync();
    if (PH(1)) {
        pg8::Gemm g{xn, Win_t, DM, DM, DM}; pg8::StaticOrder S; S.init(MTOK, INW, G, bx);
        pg8::EpiG1 E{as5, nat};
        pg8::gemm_phase<pg8::EpiG1, pg8::StaticOrder>(lds, g, S, E);
    }
    grid.sync();
#if DBG_CHECK
    for (int si = gw; si < 4096; si += NGW) chk_proj(a, chk, si, lane, as5, nat);
#endif
    if (PH(2)) {
        pg8::Gemm g{as5, PP, 384, 256, 256}; pg8::S5Order S{G, bx};
        pg8::EpiHloc E{hloc};
        pg8::gemm_phase<pg8::EpiHloc, pg8::S5Order>(lds, g, S, E);
        for (int it = bx; it < 1024; it += G) hgrn_h1(a, lds, it, tid, nat, Ut, dec);
    }
    grid.sync();
    if (PH(3)) {
        if (G > 64) {
            for (int it = bx; it < 64; it += G) s5_carry(lds, it, tid, hloc, as5, misc);
            if (bx >= 64) for (int e = (bx - 64) * 512 + tid; e < 65536; e += (G - 64) * 512) hgrn_h2(e, Ut, dec);
        } else {
            for (int it = bx; it < 64; it += G) s5_carry(lds, it, tid, hloc, as5, misc);
            for (int e = bx * 512 + tid; e < 65536; e += G * 512) hgrn_h2(e, Ut, dec);
        }
    }
    grid.sync();
    if (PH(4)) {
        pg8::Gemm g{as5, TQ, 384, 384, 384}; pg8::S5Order S{G, bx};
        pg8::EpiYg E{yg};
        pg8::gemm_phase<pg8::EpiYg, pg8::S5Order>(lds, g, S, E);
        for (int it = bx; it < 1024; it += G) hgrn_h3(a, lds, it, tid, nat, Ut, yb);
    }
    grid.sync();
#if DBG_CHECK
    for (int si = gw; si < 2048; si += NGW) chk_s5(a, chk, si, lane, as5, yg);
    for (int si = gw; si < 2048; si += NGW) chk_hgrn(a, chk, si, lane, nat, yb);
    grid.sync();
#endif
    if (PH(5)) {
        pg8::Gemm g{yg, Wglu_t, 512, 512, 512}; pg8::StaticOrder S; S.init(MTOK, 512, G, bx);
        pg8::EpiGlu E{yg, nat, a.in[12], ya};
        pg8::gemm_phase<pg8::EpiGlu, pg8::StaticOrder>(lds, g, S, E);
    }
    grid.sync();
#if DBG_CHECK
    for (int si = gw; si < 4096; si += NGW) chk_glu(a, chk, si, lane, yg, nat, ya);
#endif
    if (PH(6)) {
        pg8::StaticOrder S; S.init(MTOK, DM, G, bx);
        { pg8::Gemm g{ya, Wpa_t, 512, 512, 512}; pg8::EpiM1 E{nat, a.out}; pg8::gemm_phase<pg8::EpiM1, pg8::StaticOrder>(lds, g, S, E); }
        { pg8::Gemm g{yb, Wpb_t, 512, 512, 512}; pg8::EpiM2 E{nat, a.out}; pg8::gemm_phase<pg8::EpiM2, pg8::StaticOrder>(lds, g, S, E); }
    }
    grid.sync();
#if DBG_CHECK
    for (int si = gw; si < 4096; si += NGW) chk_merge(a, chk, si, lane, ya, yb, nat);
#endif
    if (PH(7)) {
        pg8::Gemm g{nat + NC_GB, Wout_t, NATW, DM, DM}; pg8::StaticOrder S; S.init(MTOK, DM, G, bx);
        pg8::EpiOut E{a.in[0], a.out, rowss};
        pg8::gemm_phase<pg8::EpiOut, pg8::StaticOrder>(lds, g, S, E);
    }
    grid.sync();
    if (PH(8)) for (int m = gw; m < MTOK; m += NGW) {
        f32x4* hr = (f32x4*)(a.out + (size_t)m * DM) + lane;
        float tot = 0.f;
        { const float pv = (lane < 16) ? rowss[(size_t)m * 16 + lane] : 0.f; tot = wave_sum(pv); }
        const float rs = rsqrtf(tot * (1.f / DM) + NORM_EPS);
        const f32x4* fw = (const f32x4*)a.in[18] + lane;
#pragma unroll
        for (int j = 0; j < 4; ++j) { f32x4 v = hr[64 * j]; const f32x4 w = fw[64 * j]; v = v * rs * w; hr[64 * j] = v; }
    }
#if DBG_CHECK
    grid.sync();
    if (bx == 0 && tid == 0) {
        for (int k = 1; k <= 5; ++k) {
            const float num = chk[2 * k], den = chk[2 * k + 1]; const float err = sqrtf(num / (den + 1e-30f));
            if (!(err <= 0.03f)) { float e = err; if (!(e <= 0.9f)) e = 0.9f; a.out[0] += (float)(1 << (k + 2)) * (1.f + e); break; }
        }
    }
#endif
}

extern "C" void kernel_launch(void* const* d_in, const int* in_sizes, int n_in, void* d_out, int out_size, void* d_ws, size_t ws_size, hipStream_t stream) {
    static int grid = 0;
    if (grid == 0) {
        int dev = 0, cus = 0, per_cu = 0;
        hipGetDevice(&dev);
        hipDeviceGetAttribute(&cus, hipDeviceAttributeMultiprocessorCount, dev);
        if (hipFuncSetAttribute((const void*)mega, hipFuncAttributeMaxDynamicSharedMemorySize, LDS_BYTES) != hipSuccess) fprintf(stderr, "hipFuncSetAttribute failed\n");
        if (hipOccupancyMaxActiveBlocksPerMultiprocessor(&per_cu, (const void*)mega, 512, LDS_BYTES) != hipSuccess || per_cu < 1) { fprintf(stderr, "occupancy query: %d\n", per_cu); per_cu = 1; }
        (void)hipGetLastError();
        grid = cus * 1;
        if (n_in != 19 || ws_size < WS_END) fprintf(stderr, "kernel_launch: unexpected n_in %d / ws %zu\n", n_in, ws_size);
    }
    (void)hipMemsetAsync((char*)d_ws + WS_CTL, 0, 4096, stream);
    Args a{};
    for (int i = 0; i < 19; ++i) a.in[i] = (const float*)d_in[i];
    a.out = (float*)d_out; a.ws = (unsigned char*)d_ws;
    void* args[] = {&a};
    hipError_t e = hipLaunchCooperativeKernel((const void*)mega, dim3(grid), dim3(512), args, LDS_BYTES, stream);
    if (e != hipSuccess) fprintf(stderr, "cooperative launch failed: %s (grid %d)\n", hipGetErrorString(e), grid);
}
```

```cpp
#include <hip/hip_runtime.h>
#include <hip/hip_cooperative_groups.h>
#include <cstdio>
#include <cstdint>
namespace cg = cooperative_groups;

#ifndef DBG_CHECK
#define DBG_CHECK 0
#endif
#ifndef PHASES
#define PHASES 0x1ff
#endif
#define PH(k) (((PHASES) >> (k)) & 1)
#ifndef PROBE_REP
#define PROBE_REP -1
#endif
#define REP(k) for (int rep_ = 0; rep_ < ((PROBE_REP == (k)) ? 2 : 1); ++rep_)

#define LAS __attribute__((address_space(3)))
typedef unsigned short bf16_t;
typedef short bf16x8 __attribute__((ext_vector_type(8)));
typedef float f32x4 __attribute__((ext_vector_type(4)));
typedef unsigned u32x4 __attribute__((ext_vector_type(4)));
typedef unsigned u32x2 __attribute__((ext_vector_type(2)));

constexpr int SEQ = 8192, DM = 1024, MTOK = 16384;
constexpr int INW = 5632, NATW = 5120;
constexpr float NORM_EPS = 1e-6f;
constexpr int NC_ZA = 0, NC_Q = 512, NC_F = 1024, NC_I = 1536, NC_OG = 2048, NC_ZB = 2560, NC_GA = 3072, NC_GB = 4096;

constexpr size_t MiB = 1u << 20;
constexpr size_t WS_CTL = 0;
constexpr size_t WS_WIN = 1 * MiB, WS_WGLU = 12 * MiB, WS_WPA = 13 * MiB, WS_WPB = 14 * MiB, WS_WOUT = 15 * MiB;
constexpr size_t WS_TQ = 17 * MiB, WS_PP = 23 * MiB, WS_MISC = 27 * MiB, WS_ROWSS = 28 * MiB;
constexpr size_t WS_AS5 = 29 * MiB, WS_YG = 53 * MiB, WS_YB = 69 * MiB, WS_NAT = 85 * MiB, WS_END = 245 * MiB;
constexpr size_t DO_XN = 0, DO_US = 0, DO_HLOC = 32 * MiB, DO_DEC = 48 * MiB;

__device__ __forceinline__ float bf2f(bf16_t h) { return __uint_as_float(((unsigned)h) << 16); }
__device__ __forceinline__ unsigned f2bf(float f) { unsigned u = __float_as_uint(f); return (u + 0x7fffu + ((u >> 16) & 1u)) >> 16; }
__device__ __forceinline__ unsigned pk2(float lo, float hi) { return f2bf(lo) | (f2bf(hi) << 16); }
__device__ __forceinline__ float bflo(unsigned w) { return __uint_as_float(w << 16); }
__device__ __forceinline__ float bfhi(unsigned w) { return __uint_as_float(w & 0xffff0000u); }
__device__ __forceinline__ float sigmoidf_(float x) { return __builtin_amdgcn_rcpf(1.f + __expf(-x)); }
__device__ __forceinline__ float siluf_(float x) { return x * sigmoidf_(x); }
__device__ __forceinline__ float gelu_tanh(float x) { const float u = 0.7978845608028654f * (x + 0.044715f * x * x * x); return x * sigmoidf_(2.f * u); }
__device__ __forceinline__ float wave_sum(float v) {
#pragma unroll
    for (int o = 1; o < 64; o <<= 1) v += __shfl_xor(v, o);
    return v;
}
#define LDS_WAIT() asm volatile("s_waitcnt lgkmcnt(0)" ::: "memory")
__device__ __forceinline__ int opaque_tid() { int t = threadIdx.x; asm volatile("" : "+v"(t)); return t; }

struct Args { const float* in[19]; float* out; unsigned char* ws; };

namespace pg8 {
constexpr int BM = 256, BK = 64, HALF = 128, HTB = HALF * BK * 2, STAGE_BYTES = 8 * HTB, NXCD = 8, WGM = 8;
__host__ __device__ __forceinline__ int lds_byte(int r, int c) { const int st = (r >> 4) * 2 + (c >> 5), rr = r & 15, cc = c & 31, ob = rr * 64 + cc * 2; return st * 1024 + (ob ^ (((ob >> 9) & 1) << 5)); }
__host__ __device__ __forceinline__ void stage_rc(int b, int& R, int& C) { const int st = b / 1024, sb = b % 1024, swz = sb ^ (((sb >> 9) & 1) << 5); R = (st >> 1) * 16 + swz / 64; C = (st & 1) * 32 + (swz % 64) / 2; }
__host__ __device__ __forceinline__ int perm32(int rho) { const int n = rho >> 4, i = rho & 15; return 8 * (i >> 2) + 4 * n + (i & 3); }

struct Unit { int pm, pn; };
struct Gemm { const bf16_t* A; const bf16_t* Bt; int lda, ldb, K; };

struct StaticOrder {
    int nM, nN, nwg, G, c;
    __device__ void init(int M, int N, int G_, int c_) { nM = M / BM; nN = N / BM; nwg = nM * nN; G = G_; c = c_; }
    __device__ bool next(int i, Unit& u) const {
        const long L = (long)i * G + c; if (L >= nwg) return false;
        int wgid = (int)L; { const int q = nwg / NXCD, r = nwg % NXCD, xcd = wgid % NXCD, off = wgid / NXCD; wgid = (xcd < r ? xcd * (q + 1) : r * (q + 1) + (xcd - r) * q) + off; }
        const int nig = WGM * nN, gid = wgid / nig, fm = gid * WGM, gsz = (nM - fm) < WGM ? (nM - fm) : WGM;
        u.pm = fm + ((wgid % nig) % gsz); u.pn = (wgid % nig) / gsz; return true;
    }
};
struct S5Order {
    int G, c;
    __device__ bool next(int i, Unit& u) const { const int L = i * G + c; if (L >= 128) return false; u.pm = L; u.pn = L >> 2; return true; }
};

__device__ __forceinline__ unsigned cvt_pk_bf16(float lo, float hi) { unsigned r; asm volatile("v_cvt_pk_bf16_f32 %0, %1, %2" : "=v"(r) : "v"(lo), "v"(hi)); return r; }

#define EPI_LOOP_BEGIN  _Pragma("unroll") for (int ai = 0; ai < 2; ++ai) _Pragma("unroll") for (int m = 0; m < 4; ++m) { const int row = u.pm * BM + ai * HALF + wr * 64 + m * 16 + fr; _Pragma("unroll") for (int bj = 0; bj < 2; ++bj) { const int lc = bj * HALF + wc * 32 + 8 * fq; const f32x4 v0 = acc[ai][bj][m][0], v1 = acc[ai][bj][m][1];
#define EPI_LOOP_END } }

struct EpiG1 {
    static constexpr bool PERM = true;
    bf16_t* as5; bf16_t* nat;
    __device__ __forceinline__ void operator()(const f32x4 (&acc)[2][2][4][2], const Unit& u, int wr, int wc, int fr, int fq) const {
        EPI_LOOP_BEGIN
            u32x4 w; w.x = cvt_pk_bf16(v0[0], v0[1]); w.y = cvt_pk_bf16(v0[2], v0[3]); w.z = cvt_pk_bf16(v1[0], v1[1]); w.w = cvt_pk_bf16(v1[2], v1[3]);
            if (u.pn < 2) {
                const int col = u.pn * BM + lc, g = col >> 4, p0 = col & 15, chunk = row >> 4, s = row & 15;
                *(u32x4*)(as5 + ((size_t)(g * 1024 + chunk)) * 384 + s * 16 + p0) = w;
            } else {
                *(u32x4*)(nat + (size_t)row * NATW + (u.pn * BM - 512 + lc)) = w;
            }
        EPI_LOOP_END
    }
};
struct EpiHloc {
    static constexpr bool PERM = true;
    float* hloc;
    __device__ __forceinline__ void operator()(const f32x4 (&acc)[2][2][4][2], const Unit& u, int wr, int wc, int fr, int fq) const {
        EPI_LOOP_BEGIN
            if (bj == 0) { float* p = hloc + (size_t)row * 128 + lc; *(f32x4*)p = v0; *(f32x4*)(p + 4) = v1; }
        EPI_LOOP_END
    }
};
struct EpiYg {
    static constexpr bool PERM = true;
    bf16_t* yg;
    __device__ __forceinline__ void operator()(const f32x4 (&acc)[2][2][4][2], const Unit& u, int wr, int wc, int fr, int fq) const {
        const int g = u.pn;
        EPI_LOOP_BEGIN
            const int chunk = row - g * 1024, j = lc >> 4, p0 = lc & 15;
            u32x4 w; w.x = cvt_pk_bf16(gelu_tanh(v0[0]), gelu_tanh(v0[1])); w.y = cvt_pk_bf16(gelu_tanh(v0[2]), gelu_tanh(v0[3]));
            w.z = cvt_pk_bf16(gelu_tanh(v1[0]), gelu_tanh(v1[1])); w.w = cvt_pk_bf16(gelu_tanh(v1[2]), gelu_tanh(v1[3]));
            *(u32x4*)(yg + ((size_t)(chunk * 16 + j)) * 512 + g * 16 + p0) = w;
        EPI_LOOP_END
    }
};
struct EpiGlu {
    static constexpr bool PERM = true;
    const bf16_t* yg; const bf16_t* nat; const float* bias; bf16_t* ya;
    __device__ __forceinline__ void operator()(const f32x4 (&acc)[2][2][4][2], const Unit& u, int wr, int wc, int fr, int fq) const {
        EPI_LOOP_BEGIN
            const int col = u.pn * BM + lc;
            const f32x4 b0 = *(const f32x4*)(bias + col), b1 = *(const f32x4*)(bias + col + 4);
            const u32x4 y = *(const u32x4*)(yg + (size_t)row * 512 + col), z = *(const u32x4*)(nat + (size_t)row * NATW + NC_ZA + col);
            float o[8];
            o[0] = bflo(y.x) * sigmoidf_(v0[0] + b0[0]) * siluf_(bflo(z.x)); o[1] = bfhi(y.x) * sigmoidf_(v0[1] + b0[1]) * siluf_(bfhi(z.x));
            o[2] = bflo(y.y) * sigmoidf_(v0[2] + b0[2]) * siluf_(bflo(z.y)); o[3] = bfhi(y.y) * sigmoidf_(v0[3] + b0[3]) * siluf_(bfhi(z.y));
            o[4] = bflo(y.z) * sigmoidf_(v1[0] + b1[0]) * siluf_(bflo(z.z)); o[5] = bfhi(y.z) * sigmoidf_(v1[1] + b1[1]) * siluf_(bfhi(z.z));
            o[6] = bflo(y.w) * sigmoidf_(v1[2] + b1[2]) * siluf_(bflo(z.w)); o[7] = bfhi(y.w) * sigmoidf_(v1[3] + b1[3]) * siluf_(bfhi(z.w));
            u32x4 w; w.x = cvt_pk_bf16(o[0], o[1]); w.y = cvt_pk_bf16(o[2], o[3]); w.z = cvt_pk_bf16(o[4], o[5]); w.w = cvt_pk_bf16(o[6], o[7]);
            *(u32x4*)(ya + (size_t)row * 512 + col) = w;
        EPI_LOOP_END
    }
};
struct EpiM1 {
    static constexpr bool PERM = true;
    const bf16_t* nat; float* tmp;
    __device__ __forceinline__ void operator()(const f32x4 (&acc)[2][2][4][2], const Unit& u, int wr, int wc, int fr, int fq) const {
        EPI_LOOP_BEGIN
            const int col = u.pn * BM + lc;
            const u32x4 gq = *(const u32x4*)(nat + (size_t)row * NATW + NC_GA + col);
            f32x4 o0, o1;
            o0[0] = sigmoidf_(bflo(gq.x)) * v0[0]; o0[1] = sigmoidf_(bfhi(gq.x)) * v0[1]; o0[2] = sigmoidf_(bflo(gq.y)) * v0[2]; o0[3] = sigmoidf_(bfhi(gq.y)) * v0[3];
            o1[0] = sigmoidf_(bflo(gq.z)) * v1[0]; o1[1] = sigmoidf_(bfhi(gq.z)) * v1[1]; o1[2] = sigmoidf_(bflo(gq.w)) * v1[2]; o1[3] = sigmoidf_(bfhi(gq.w)) * v1[3];
            float* p = tmp + (size_t)row * DM + col; *(f32x4*)p = o0; *(f32x4*)(p + 4) = o1;
        EPI_LOOP_END
    }
};
struct EpiM2 {
    static constexpr bool PERM = true;
    bf16_t* nat; const float* tmp;
    __device__ __forceinline__ void operator()(const f32x4 (&acc)[2][2][4][2], const Unit& u, int wr, int wc, int fr, int fq) const {
        EPI_LOOP_BEGIN
            const int col = u.pn * BM + lc;
            bf16_t* gp = nat + (size_t)row * NATW + NC_GB + col;
            const u32x4 gq = *(const u32x4*)gp;
            const float* p = tmp + (size_t)row * DM + col; const f32x4 t0 = *(const f32x4*)p, t1 = *(const f32x4*)(p + 4);
            float o[8];
            o[0] = t0[0] + sigmoidf_(bflo(gq.x)) * v0[0]; o[1] = t0[1] + sigmoidf_(bfhi(gq.x)) * v0[1]; o[2] = t0[2] + sigmoidf_(bflo(gq.y)) * v0[2]; o[3] = t0[3] + sigmoidf_(bfhi(gq.y)) * v0[3];
            o[4] = t1[0] + sigmoidf_(bflo(gq.z)) * v1[0]; o[5] = t1[1] + sigmoidf_(bfhi(gq.z)) * v1[1]; o[6] = t1[2] + sigmoidf_(bflo(gq.w)) * v1[2]; o[7] = t1[3] + sigmoidf_(bfhi(gq.w)) * v1[3];
            u32x4 w; w.x = cvt_pk_bf16(o[0], o[1]); w.y = cvt_pk_bf16(o[2], o[3]); w.z = cvt_pk_bf16(o[4], o[5]); w.w = cvt_pk_bf16(o[6], o[7]);
            *(u32x4*)gp = w;
        EPI_LOOP_END
    }
};
struct EpiOut {
    static constexpr bool PERM = true;
    const float* x; float* out; float* rowss;
    __device__ __forceinline__ void operator()(const f32x4 (&acc)[2][2][4][2], const Unit& u, int wr, int wc, int fr, int fq) const {
#pragma unroll
        for (int ai = 0; ai < 2; ++ai)
#pragma unroll
            for (int m = 0; m < 4; ++m) {
                const int row = u.pm * BM + ai * HALF + wr * 64 + m * 16 + fr; float ss = 0.f;
#pragma unroll
                for (int bj = 0; bj < 2; ++bj) {
                    const int col = u.pn * BM + bj * HALF + wc * 32 + 8 * fq;
                    const float* xp = x + (size_t)row * DM + col; float* op = out + (size_t)row * DM + col;
                    const f32x4 h0 = *(const f32x4*)xp + acc[ai][bj][m][0], h1 = *(const f32x4*)(xp + 4) + acc[ai][bj][m][1];
                    *(f32x4*)op = h0; *(f32x4*)(op + 4) = h1;
                    ss += (h0[0] * h0[0] + h0[1] * h0[1]) + (h0[2] * h0[2] + h0[3] * h0[3]) + (h1[0] * h1[0] + h1[1] * h1[1]) + (h1[2] * h1[2] + h1[3] * h1[3]);
                }
                ss += __shfl_xor(ss, 16); ss += __shfl_xor(ss, 32);
                if (fq == 0) rowss[(size_t)row * 16 + u.pn * 4 + wc] = ss;
            }
    }
};

template <class Epi, class Sched, bool ALIGN_EPI = true, bool SP2 = true>
__device__ __forceinline__ void gemm_phase(LAS unsigned char* lds, const Gemm g, const Sched& S, const Epi& E) {
    const int tid = opaque_tid(), wid = __builtin_amdgcn_readfirstlane(tid >> 6), lane = tid & 63, wr = wid >> 2, wc = wid & 3, fr = lane & 15, fq = lane >> 4;
    const int K = g.K, nt = K / BK;
    unsigned voffA[2], voffB[2];
#pragma unroll
    for (int i = 0; i < 2; ++i) { int R, C; stage_rc(tid * 16 + i * 8192, R, C); const int Rb = Epi::PERM ? ((R & ~31) + perm32(R & 31)) : R;
        voffA[i] = (unsigned)(R * g.lda + C) * 2u; voffB[i] = (unsigned)(Rb * g.ldb + C) * 2u; }
    const size_t kstep = (size_t)(BK * 2);
    const size_t hstepA = (size_t)HALF * g.lda * 2, hstepB = (size_t)HALF * g.ldb * 2;
    const size_t tstepA = 2 * hstepA, tstepB = 2 * hstepB;
    const unsigned ldsw = (unsigned)wid * 1024u;
    const int aoff = lds_byte(wr * 64 + fr, fq * 8), boff = lds_byte(wc * 32 + fr, fq * 8);
#define PG8_SA(b, h) (((b) * 2 + (h)) * HTB)
#define PG8_SB(b, h) ((4 + (b) * 2 + (h)) * HTB)
#define PG8_STAGE(bufoff, gbase, voff) do { _Pragma("unroll") for (int _i = 0; _i < 2; ++_i) \
        __builtin_amdgcn_global_load_lds((const unsigned*)((const char*)(gbase) + (voff)[_i]), (LAS unsigned*)(lds + (bufoff) + ldsw + _i * 8192), 16, 0, 0); } while (0)
#define PG8_LDA(dst, b, h) do { _Pragma("unroll") for (int m = 0; m < 4; ++m) _Pragma("unroll") for (int k = 0; k < 2; ++k) dst[m][k] = *(const LAS bf16x8*)(lds + PG8_SA(b, h) + aoff + m * 2048 + k * 1024); } while (0)
#define PG8_LDB(dst, b, h) do { _Pragma("unroll") for (int n = 0; n < 2; ++n) _Pragma("unroll") for (int k = 0; k < 2; ++k) dst[n][k] = *(const LAS bf16x8*)(lds + PG8_SB(b, h) + boff + n * 2048 + k * 1024); } while (0)
#define PG8_MMA(ai, bj, At, Bt) do { __builtin_amdgcn_s_setprio(1); _Pragma("unroll") for (int m = 0; m < 4; ++m) _Pragma("unroll") for (int n = 0; n < 2; ++n) _Pragma("unroll") for (int k = 0; k < 2; ++k) \
        acc[ai][bj][m][n] = __builtin_amdgcn_mfma_f32_16x16x32_bf16(Bt[n][k], At[m][k], acc[ai][bj][m][n], 0, 0, 0); __builtin_amdgcn_s_setprio(0); } while (0)
#define PG8_WAIT_V(n) asm volatile("s_waitcnt vmcnt(" #n ")" ::: "memory")
#define PG8_WAIT_L(n) asm volatile("s_waitcnt lgkmcnt(" #n ")" ::: "memory")
#define PG8_BAR __builtin_amdgcn_s_barrier()
#define PG8_SCHED __builtin_amdgcn_sched_barrier(0)
    Unit cur, nxt; int ui = 0;
    if (!S.next(0, cur)) return;
    f32x4 acc[2][2][4][2];
#pragma unroll
    for (int a = 0; a < 2; ++a)
#pragma unroll
        for (int b = 0; b < 2; ++b)
#pragma unroll
            for (int m = 0; m < 4; ++m)
#pragma unroll
                for (int n = 0; n < 2; ++n) acc[a][b][m][n] = (f32x4){0.f, 0.f, 0.f, 0.f};
    bf16x8 At[4][2], B0[2][2], B1[2][2];
    const char* cA = (const char*)g.A + (size_t)cur.pm * tstepA; const char* cB = (const char*)g.Bt + (size_t)cur.pn * tstepB;
    if constexpr (SP2) {
        PG8_STAGE(PG8_SB(0, 0), cB, voffB); PG8_STAGE(PG8_SB(0, 1), cB + hstepB, voffB); PG8_STAGE(PG8_SA(0, 0), cA, voffA); PG8_STAGE(PG8_SA(0, 1), cA + hstepA, voffA);
        if (wr == 1) PG8_BAR;
        PG8_WAIT_V(2); PG8_BAR;
        PG8_STAGE(PG8_SB(1, 0), cB + kstep, voffB); PG8_STAGE(PG8_SA(1, 0), cA + kstep, voffA); PG8_STAGE(PG8_SB(1, 1), cB + hstepB + kstep, voffB);
        PG8_WAIT_V(6); PG8_BAR;
    } else {
        PG8_STAGE(PG8_SB(0, 0), cB, voffB); PG8_STAGE(PG8_SA(0, 0), cA, voffA); PG8_STAGE(PG8_SB(0, 1), cB + hstepB, voffB); PG8_STAGE(PG8_SA(0, 1), cA + hstepA, voffA);
        if (wr == 1) PG8_BAR;
        PG8_WAIT_V(4); PG8_BAR;
        PG8_STAGE(PG8_SB(1, 0), cB + kstep, voffB); PG8_STAGE(PG8_SA(1, 0), cA + kstep, voffA); PG8_STAGE(PG8_SB(1, 1), cB + hstepB + kstep, voffB);
        PG8_WAIT_V(6); PG8_BAR;
    }
    for (;;) {
        const bool has_next = S.next(ui + 1, nxt);
        const char* nA = has_next ? (const char*)g.A + (size_t)nxt.pm * tstepA : cA; const char* nB = has_next ? (const char*)g.Bt + (size_t)nxt.pn * tstepB : cB;
        for (int t = 0; t < nt; t += 2) {
            const bool last = (t == nt - 2);
            const char* a1 = cA + (size_t)(t + 1) * kstep;
            const char* a2 = last ? nA : cA + (size_t)(t + 2) * kstep; const char* b2 = last ? nB : cB + (size_t)(t + 2) * kstep;
            const char* a3 = a2 + kstep; const char* b3 = b2 + kstep;
            if constexpr (SP2) {
            PG8_LDB(B0, 0, 0); PG8_LDB(B1, 0, 1); PG8_SCHED; PG8_LDA(At, 0, 0); PG8_STAGE(PG8_SA(1, 1), a1 + hstepA, voffA);
            PG8_WAIT_V(8); PG8_WAIT_L(0); PG8_BAR; PG8_MMA(0, 0, At, B0); PG8_MMA(0, 1, At, B1); PG8_BAR; PG8_SCHED;
            PG8_LDA(At, 0, 1); PG8_STAGE(PG8_SB(0, 0), b2, voffB); PG8_STAGE(PG8_SB(0, 1), b2 + hstepB, voffB); PG8_STAGE(PG8_SA(0, 0), a2, voffA);
            PG8_WAIT_V(8); PG8_WAIT_L(0); PG8_BAR; PG8_MMA(1, 0, At, B0); PG8_MMA(1, 1, At, B1); PG8_BAR; PG8_SCHED;
            PG8_LDB(B0, 1, 0); PG8_LDB(B1, 1, 1); PG8_SCHED; PG8_LDA(At, 1, 0); PG8_STAGE(PG8_SA(0, 1), a2 + hstepA, voffA);
            PG8_WAIT_V(8); PG8_WAIT_L(0); PG8_BAR; PG8_MMA(0, 0, At, B0); PG8_MMA(0, 1, At, B1); PG8_BAR; PG8_SCHED;
            PG8_LDA(At, 1, 1); PG8_STAGE(PG8_SB(1, 0), b3, voffB); PG8_STAGE(PG8_SB(1, 1), b3 + hstepB, voffB); PG8_STAGE(PG8_SA(1, 0), a3, voffA);
            PG8_WAIT_V(8); PG8_WAIT_L(0); PG8_BAR; PG8_MMA(1, 0, At, B0); PG8_MMA(1, 1, At, B1); PG8_BAR; PG8_SCHED;
            } else {
            PG8_LDB(B0, 0, 0); PG8_SCHED; PG8_LDA(At, 0, 0); PG8_STAGE(PG8_SA(1, 1), a1 + hstepA, voffA);
            PG8_WAIT_L(8); PG8_BAR; PG8_WAIT_L(0); PG8_MMA(0, 0, At, B0); PG8_BAR; PG8_SCHED;
            PG8_LDB(B1, 0, 1); PG8_STAGE(PG8_SB(0, 0), b2, voffB);
            PG8_BAR; PG8_WAIT_L(0); PG8_MMA(0, 1, At, B1); PG8_BAR;
            PG8_LDA(At, 0, 1); PG8_STAGE(PG8_SA(0, 0), a2, voffA);
            PG8_BAR; PG8_WAIT_L(0); PG8_MMA(1, 0, At, B0); PG8_BAR; PG8_SCHED;
            PG8_STAGE(PG8_SB(0, 1), b2 + hstepB, voffB);
            PG8_WAIT_V(6); PG8_BAR; PG8_MMA(1, 1, At, B1); PG8_BAR;
            PG8_LDB(B0, 1, 0); PG8_SCHED; PG8_LDA(At, 1, 0); PG8_STAGE(PG8_SA(0, 1), a2 + hstepA, voffA);
            PG8_WAIT_L(8); PG8_BAR; PG8_WAIT_L(0); PG8_MMA(0, 0, At, B0); PG8_BAR; PG8_SCHED;
            PG8_LDB(B1, 1, 1); PG8_STAGE(PG8_SB(1, 0), b3, voffB);
            PG8_BAR; PG8_WAIT_L(0); PG8_MMA(0, 1, At, B1); PG8_BAR;
            PG8_LDA(At, 1, 1); PG8_STAGE(PG8_SA(1, 0), a3, voffA);
            PG8_BAR; PG8_WAIT_L(0); PG8_MMA(1, 0, At, B0); PG8_BAR; PG8_SCHED;
            PG8_STAGE(PG8_SB(1, 1), b3 + hstepB, voffB);
            PG8_WAIT_V(6); PG8_BAR; PG8_MMA(1, 1, At, B1); PG8_BAR;
            }
        }
        if constexpr (ALIGN_EPI) { if (wr == 0) PG8_BAR; }
        E(acc, cur, wr, wc, fr, fq);
        if (!has_next) break;
#pragma unroll
        for (int a = 0; a < 2; ++a)
#pragma unroll
            for (int b = 0; b < 2; ++b)
#pragma unroll
                for (int m = 0; m < 4; ++m)
#pragma unroll
                    for (int n = 0; n < 2; ++n) acc[a][b][m][n] = (f32x4){0.f, 0.f, 0.f, 0.f};
        cur = nxt; cA = nA; cB = nB; ++ui;
        if constexpr (ALIGN_EPI) { if (wr == 1) PG8_BAR; }
    }
    PG8_WAIT_V(0);
    if constexpr (!ALIGN_EPI) { if (wr == 0) PG8_BAR; }
    PG8_BAR;
#undef PG8_SA
#undef PG8_SB
#undef PG8_STAGE
#undef PG8_LDA
#undef PG8_LDB
#undef PG8_MMA
#undef PG8_WAIT_V
#undef PG8_WAIT_L
#undef PG8_BAR
#undef PG8_SCHED
}
}

__device__ __forceinline__ void p0_transpose_item(const float* W, int K, int N, bf16_t* WT, const float* scale, LAS float* scr, int item, int lane) {
    const int nblk = N / 32, kb = item / nblk, nb = item % nblk, k0 = 64 * kb, n0 = 32 * nb;
#pragma unroll 8
    for (int i = 0; i < 32; ++i) { const int kk = 2 * i + (lane >> 5); float v = W[(size_t)(k0 + kk) * N + n0 + (lane & 31)]; if (scale) v *= scale[k0 + kk]; scr[kk * 33 + (lane & 31)] = v; }
    LDS_WAIT(); asm volatile("" ::: "memory");
    const int c = lane & 7;
#pragma unroll
    for (int j = 0; j < 4; ++j) { const int n = (lane >> 3) + 8 * j; const LAS float* s = scr + (8 * c) * 33 + n;
        u32x4 o; o.x = pk2(s[0 * 33], s[1 * 33]); o.y = pk2(s[2 * 33], s[3 * 33]); o.z = pk2(s[4 * 33], s[5 * 33]); o.w = pk2(s[6 * 33], s[7 * 33]);
        *(u32x4*)(WT + (size_t)(n0 + n) * K + k0 + 8 * c) = o; }
    LDS_WAIT(); asm volatile("" ::: "memory");
}

__device__ __forceinline__ void sincos_d(double x, double& s, double& c) {
    const double k = rint(x * 0.6366197723675814);
    double r = fma(-k, 1.5707963267948966, x); r = fma(-k, 6.123233995736766e-17, r);
    const double r2 = r * r;
    double ps = 1.0 / 6227020800.0; ps = fma(ps, r2, -1.0 / 39916800.0); ps = fma(ps, r2, 1.0 / 362880.0); ps = fma(ps, r2, -1.0 / 5040.0); ps = fma(ps, r2, 1.0 / 120.0); ps = fma(ps, r2, -1.0 / 6.0); ps = fma(ps, r2, 1.0);
    const double sr = r * ps;
    double pc = -1.0 / 87178291200.0; pc = fma(pc, r2, 1.0 / 479001600.0); pc = fma(pc, r2, -1.0 / 3628800.0); pc = fma(pc, r2, 1.0 / 40320.0); pc = fma(pc, r2, -1.0 / 720.0); pc = fma(pc, r2, 1.0 / 24.0); pc = fma(pc, r2, -0.5); pc = fma(pc, r2, 1.0);
    const int q = (int)(((long long)k) & 3);
    s = (q == 0) ? sr : (q == 1) ? pc : (q == 2) ? -sr : -pc;
    c = (q == 0) ? pc : (q == 1) ? -sr : (q == 2) ? -pc : sr;
}
__device__ __forceinline__ void s5_pow(double lr, double li, double dt, double tau, double& re, double& im) {
    const double mag = exp(lr * dt * tau); double s, c; sincos_d(li * dt * tau, s, c); re = mag * c; im = mag * s;
}

__device__ __forceinline__ void s5_build(const Args& a, int g, LAS unsigned char* lds, int tid_, bf16_t* TQ, bf16_t* PP, float* misc) {
    const int tid = opaque_tid();
    LAS float* pwr = (LAS float*)lds;
    LAS float* pwi = pwr + 17 * 64;
    LAS float* bbr = pwi + 17 * 64;
    LAS float* bbi = bbr + 1024;
    LAS float* cre = bbi + 1024;
    LAS float* cim = cre + 1024;
    LAS float* Kt = cim + 1024;
    if (tid < 64) {
        const int n = tid;
        const double dt = exp((double)a.in[10][g]);
        const double lr = (double)fminf(a.in[3][g * 64 + n], -1e-4f), li = (double)a.in[4][g * 64 + n];
        double are = 1.0, aim = 0.0;
        for (int tau = 0; tau <= 16; ++tau) { double re, im; s5_pow(lr, li, dt, (double)tau, re, im); pwr[tau * 64 + n] = (float)re; pwi[tau * 64 + n] = (float)im; if (tau == 1) { are = re; aim = im; } }
        const double den = lr * lr + li * li, nr = are - 1.0;
        const double cr = (nr * lr + aim * li) / den, ci = (aim * lr - nr * li) / den;
        for (int p = 0; p < 16; ++p) { const double br = (double)a.in[5][(g * 64 + n) * 16 + p], bi = (double)a.in[6][(g * 64 + n) * 16 + p];
            bbr[n * 16 + p] = (float)(cr * br - ci * bi); bbi[n * 16 + p] = (float)(cr * bi + ci * br); }
        double r2, i2; s5_pow(lr, li, dt, 1024.0, r2, i2);
        float* mp = misc + (size_t)(g * 64 + n) * 4; mp[0] = pwr[16 * 64 + n]; mp[1] = pwi[16 * 64 + n]; mp[2] = (float)r2; mp[3] = (float)i2;
    }
    for (int e = tid; e < 1024; e += 512) { cre[e] = a.in[7][g * 1024 + e]; cim[e] = a.in[8][g * 1024 + e]; }
    __syncthreads();
    for (int e = tid; e < 4096; e += 512) {
        const int tau = e >> 8, p = (e >> 4) & 15, pp = e & 15; float s = 0.f;
        for (int n = 0; n < 64; ++n) { const float pr = pwr[tau * 64 + n], pi = pwi[tau * 64 + n], br = bbr[n * 16 + pp], bi = bbi[n * 16 + pp];
            const float wre = pr * br - pi * bi, wim = pr * bi + pi * br; s += cre[p * 64 + n] * wre - cim[p * 64 + n] * wim; }
        if (tau == 0 && p == pp) s += a.in[9][g * 16 + p];
        Kt[e] = s;
    }
    __syncthreads();
    for (int e = tid; e < 256 * 384; e += 512) {
        const int row = e / 384, col = e - row * 384, j = row >> 4, p = row & 15; float v;
        if (col < 256) { const int s = col >> 4, pp = col & 15; v = (s <= j) ? Kt[((j - s) * 16 + p) * 16 + pp] : 0.f; }
        else { const int nn = col - 256, n = nn & 63; const float ar = pwr[(j + 1) * 64 + n], ai = pwi[(j + 1) * 64 + n], cr = cre[p * 64 + n], ci = cim[p * 64 + n];
            v = (nn < 64) ? (cr * ar - ci * ai) : -(cr * ai + ci * ar); }
        TQ[(size_t)(g * 256 + row) * 384 + col] = (bf16_t)f2bf(v);
    }
    for (int e = tid; e < 256 * 256; e += 512) {
        const int row = e >> 8, col = e & 255; float v = 0.f;
        if (row < 128) { const int n = row & 63, s = col >> 4, pp = col & 15; const float pr = pwr[(15 - s) * 64 + n], pi = pwi[(15 - s) * 64 + n], br = bbr[n * 16 + pp], bi = bbi[n * 16 + pp];
            v = (row < 64) ? (pr * br - pi * bi) : (pr * bi + pi * br); }
        PP[(size_t)(g * 256 + row) * 256 + col] = (bf16_t)f2bf(v);
    }
    __syncthreads();
}

__device__ __forceinline__ float hgrn_lb(const float* lg, int w) { return 1.f / (1.f + expf(lg[512 + w] - lg[w])); }

__device__ __forceinline__ void hgrn_h1(const Args& a, LAS unsigned char* lds, int item, int tid_, const bf16_t* nat, bf16_t* Ut, float* dec) {
    const int tid = opaque_tid();
    const int bh = item >> 7, c = item & 127, b = bh >> 2, h = bh & 3;
    const size_t row0 = (size_t)b * SEQ + (size_t)c * 64;
    LAS float* G32 = (LAS float*)lds;
    LAS float* KEY = G32 + 8192;
    LAS bf16_t* KLT = (LAS bf16_t*)(lds + 65536);
    LAS bf16_t* VT = KLT + 128 * 72;
    const int k = tid & 127;
    const float lbv = hgrn_lb(a.in[13], h * 128 + k);
    for (int e = tid; e < 8192; e += 512) {
        const int t = e >> 7; const bf16_t* r = nat + (row0 + t) * NATW + h * 128 + k;
        const float f = bf2f(r[NC_F]);
        const float sg = 1.f / (1.f + expf(-f)), sn = 1.f / (1.f + expf(f));
        G32[e] = logf(lbv + (1.f - lbv) * sg);
        KEY[e] = (1.f - lbv) * sn;
        VT[k * 72 + t] = r[NC_I];
    }
    __syncthreads();
    if (tid < 128) { float cum = 0.f; for (int t = 0; t < 64; ++t) { cum += G32[t * 128 + tid]; G32[t * 128 + tid] = cum; } }
    __syncthreads();
    { const float last = G32[63 * 128 + k];
      for (int e = tid; e < 8192; e += 512) { const int t = e >> 7; KLT[k * 72 + t] = (bf16_t)f2bf(KEY[e] * expf(last - G32[e])); }
      if (tid < 128) dec[(size_t)item * 128 + tid] = expf(last); }
    __syncthreads();
    const int w = tid >> 6, lane = tid & 63, fr = lane & 15, fq = lane >> 4, k0 = 16 * w;
    const bf16x8 a0 = *(const LAS bf16x8*)(KLT + (k0 + fr) * 72 + fq * 8), a1 = *(const LAS bf16x8*)(KLT + (k0 + fr) * 72 + 32 + fq * 8);
#pragma unroll
    for (int vt = 0; vt < 8; ++vt) {
        const bf16x8 b0 = *(const LAS bf16x8*)(VT + (vt * 16 + fr) * 72 + fq * 8), b1 = *(const LAS bf16x8*)(VT + (vt * 16 + fr) * 72 + 32 + fq * 8);
        f32x4 acc = (f32x4){0.f, 0.f, 0.f, 0.f};
        acc = __builtin_amdgcn_mfma_f32_16x16x32_bf16(a0, b0, acc, 0, 0, 0);
        acc = __builtin_amdgcn_mfma_f32_16x16x32_bf16(a1, b1, acc, 0, 0, 0);
        u32x2 o; o.x = pk2(acc[0], acc[1]); o.y = pk2(acc[2], acc[3]);
        *(u32x2*)(Ut + (size_t)item * 16384 + (vt * 16 + fr) * 128 + k0 + 4 * fq) = o;
    }
    __syncthreads();
}

__device__ __forceinline__ void hgrn_h2(int e, bf16_t* Ut, const float* dec) {
    const int bh = e >> 13, rem = e & 8191, v = rem >> 6, k = (rem & 63) * 2;
    unsigned* up = (unsigned*)(Ut + (size_t)bh * 128 * 16384 + v * 128 + k);
    const float* dp = dec + (size_t)bh * 128 * 128 + k;
    float s0 = 0.f, s1 = 0.f;
    for (int c0 = 0; c0 < 128; c0 += 16) {
        unsigned uu[16]; float d0[16], d1[16];
#pragma unroll
        for (int i = 0; i < 16; ++i) { uu[i] = up[(size_t)(c0 + i) * 8192]; const float2 dd = *(const float2*)(dp + (size_t)(c0 + i) * 128); d0[i] = dd.x; d1[i] = dd.y; }
#pragma unroll
        for (int i = 0; i < 16; ++i) { up[(size_t)(c0 + i) * 8192] = pk2(s0, s1); s0 = d0[i] * s0 + bflo(uu[i]); s1 = d1[i] * s1 + bfhi(uu[i]); }
    }
}

__device__ __forceinline__ void hgrn_h3(const Args& a, LAS unsigned char* lds, int item, int tid_, const bf16_t* nat, const bf16_t* St, bf16_t* yb) {
    const int tid = opaque_tid();
    const int bh = item >> 7, c = item & 127, b = bh >> 2, h = bh & 3;
    const size_t row0 = (size_t)b * SEQ + (size_t)c * 64;
    LAS float* CUM = (LAS float*)lds;
    LAS bf16_t* QD = (LAS bf16_t*)(lds + 32768);
    LAS bf16_t* KD = QD + 64 * 136;
    LAS bf16_t* VT = KD + 64 * 136;
    LAS bf16_t* PS = VT + 128 * 72;
    LAS float* SS = (LAS float*)(lds + 32768 + 2 * 64 * 136 * 2 + 128 * 72 * 2 + 64 * 72 * 2);
    const int k = tid & 127;
    const float lbv = hgrn_lb(a.in[13], h * 128 + k);
    for (int e = tid; e < 8192; e += 512) {
        const int t = e >> 7; const bf16_t* r = nat + (row0 + t) * NATW + h * 128 + k;
        const float f = bf2f(r[NC_F]);
        CUM[e] = logf(lbv + (1.f - lbv) / (1.f + expf(-f)));
        VT[k * 72 + t] = r[NC_I];
    }
    __syncthreads();
    if (tid < 128) { float cum = 0.f; for (int t = 0; t < 64; ++t) { cum += CUM[t * 128 + tid]; CUM[t * 128 + tid] = cum; } }
    __syncthreads();
    for (int e = tid; e < 8192; e += 512) {
        const int t = e >> 7; const bf16_t* r = nat + (row0 + t) * NATW + h * 128 + k;
        const float f = bf2f(r[NC_F]), q = bf2f(r[NC_Q]), cum = CUM[e];
        const float key = (1.f - lbv) / (1.f + expf(f));
        QD[t * 136 + k] = (bf16_t)f2bf(q / (1.f + expf(-q)) * expf(cum));
        KD[t * 136 + k] = (bf16_t)f2bf(key * expf(-cum));
    }
    __syncthreads();
    const int w = tid >> 6, lane = tid & 63, fr = lane & 15, fq = lane >> 4;
    {
        const int tt = w >> 1;
        bf16x8 qa[4];
#pragma unroll
        for (int ks = 0; ks < 4; ++ks) qa[ks] = *(const LAS bf16x8*)(QD + (tt * 16 + fr) * 136 + ks * 32 + fq * 8);
#pragma unroll
        for (int si = 0; si < 2; ++si) {
            const int st = 2 * (w & 1) + si;
            f32x4 acc = (f32x4){0.f, 0.f, 0.f, 0.f};
            if (st <= tt) {
#pragma unroll
                for (int ks = 0; ks < 4; ++ks) { const bf16x8 kb = *(const LAS bf16x8*)(KD + (st * 16 + fr) * 136 + ks * 32 + fq * 8); acc = __builtin_amdgcn_mfma_f32_16x16x32_bf16(qa[ks], kb, acc, 0, 0, 0); }
            }
#pragma unroll
            for (int j = 0; j < 4; ++j) { const int t = tt * 16 + 4 * fq + j, s = st * 16 + fr; PS[t * 72 + s] = (bf16_t)f2bf((s <= t) ? acc[j] : 0.f); }
        }
    }
    __syncthreads();
    const int v0 = 16 * w;
    bf16x8 sb[4], vb[2];
#pragma unroll
    for (int ks = 0; ks < 4; ++ks) sb[ks] = *(const bf16x8*)(St + (size_t)item * 16384 + (v0 + fr) * 128 + ks * 32 + fq * 8);
#pragma unroll
    for (int ks = 0; ks < 2; ++ks) vb[ks] = *(const LAS bf16x8*)(VT + (v0 + fr) * 72 + ks * 32 + fq * 8);
    f32x4 o[4];
#pragma unroll
    for (int tt = 0; tt < 4; ++tt) {
        f32x4 acc = (f32x4){0.f, 0.f, 0.f, 0.f};
#pragma unroll
        for (int ks = 0; ks < 2; ++ks) { const bf16x8 pa = *(const LAS bf16x8*)(PS + (tt * 16 + fr) * 72 + ks * 32 + fq * 8); acc = __builtin_amdgcn_mfma_f32_16x16x32_bf16(pa, vb[ks], acc, 0, 0, 0); }
#pragma unroll
        for (int ks = 0; ks < 4; ++ks) { const bf16x8 qa = *(const LAS bf16x8*)(QD + (tt * 16 + fr) * 136 + ks * 32 + fq * 8); acc = __builtin_amdgcn_mfma_f32_16x16x32_bf16(qa, sb[ks], acc, 0, 0, 0); }
        o[tt] = acc;
    }
    const int vcol = h * 128 + v0 + fr;
#pragma unroll
    for (int tt = 0; tt < 4; ++tt)
#pragma unroll
        for (int j = 0; j < 4; ++j) {
            const int t = tt * 16 + 4 * fq + j;
            const float og = bf2f(nat[(row0 + t) * NATW + NC_OG + vcol]);
            const float val = o[tt][j] / (1.f + expf(-og)); o[tt][j] = val;
            float ss = val * val; ss += __shfl_xor(ss, 1); ss += __shfl_xor(ss, 2); ss += __shfl_xor(ss, 4); ss += __shfl_xor(ss, 8);
            if (fr == 0) SS[w * 64 + t] = ss;
        }
    __syncthreads();
    const float hw = a.in[14][vcol];
#pragma unroll
    for (int tt = 0; tt < 4; ++tt)
#pragma unroll
        for (int j = 0; j < 4; ++j) {
            const int t = tt * 16 + 4 * fq + j; float tot = 0.f;
#pragma unroll
            for (int ww = 0; ww < 8; ++ww) tot += SS[ww * 64 + t];
            const float rs = rsqrtf(tot * (1.f / 128.f) + NORM_EPS);
            const float zb = bf2f(nat[(row0 + t) * NATW + NC_ZB + vcol]);
            yb[(row0 + t) * 512 + vcol] = (bf16_t)f2bf(o[tt][j] * rs * hw * (zb / (1.f + expf(-zb))));
        }
    __syncthreads();
}

__device__ __forceinline__ void s5_carry(LAS unsigned char* lds, int item, int tid_, const float* hloc, bf16_t* as5, const float* misc) {
    const int tid = opaque_tid();
    const int b = item >> 5, g = item & 31, n = tid & 63, seg = tid >> 6;
    LAS float* E = (LAS float*)lds;
    const float* mp = misc + (size_t)(g * 64 + n) * 4;
    const float ar = mp[0], ai = mp[1], Ar = mp[2], Ai = mp[3];
    const size_t R0 = (size_t)g * 1024 + (size_t)b * 512 + (size_t)seg * 64;
    const float* hp = hloc + R0 * 128 + n;
    float hr = 0.f, hi = 0.f;
    for (int c0 = 0; c0 < 64; c0 += 16) {
        float lr[16], li[16];
#pragma unroll
        for (int i = 0; i < 16; ++i) { lr[i] = hp[(size_t)(c0 + i) * 128]; li[i] = hp[(size_t)(c0 + i) * 128 + 64]; }
#pragma unroll
        for (int i = 0; i < 16; ++i) { const float nr = ar * hr - ai * hi + lr[i], ni = ar * hi + ai * hr + li[i]; hr = nr; hi = ni; }
    }
    E[(seg * 64 + n) * 2] = hr; E[(seg * 64 + n) * 2 + 1] = hi;
    __syncthreads();
    hr = 0.f; hi = 0.f;
    for (int j = 0; j < seg; ++j) { const float er = E[(j * 64 + n) * 2], ei = E[(j * 64 + n) * 2 + 1]; const float nr = Ar * hr - Ai * hi + er, ni = Ar * hi + Ai * hr + ei; hr = nr; hi = ni; }
    bf16_t* op = as5 + R0 * 384 + 256 + n;
    for (int c0 = 0; c0 < 64; c0 += 16) {
        float lr[16], li[16];
#pragma unroll
        for (int i = 0; i < 16; ++i) { lr[i] = hp[(size_t)(c0 + i) * 128]; li[i] = hp[(size_t)(c0 + i) * 128 + 64]; }
#pragma unroll
        for (int i = 0; i < 16; ++i) { op[(size_t)(c0 + i) * 384] = (bf16_t)f2bf(hr); op[(size_t)(c0 + i) * 384 + 64] = (bf16_t)f2bf(hi);
            const float nr = ar * hr - ai * hi + lr[i], ni = ar * hi + ai * hr + li[i]; hr = nr; hi = ni; }
    }
    __syncthreads();
}

#if DBG_CHECK
__device__ __forceinline__ unsigned hash_u(unsigned x) { x ^= x >> 16; x *= 0x7feb352dU; x ^= x >> 15; x *= 0x846ca68bU; x ^= x >> 16; return x; }
__device__ __forceinline__ void chk_add(float* chk, int k, float opt, float ref, int lane) { if (lane == 0) { const float d = opt - ref; atomicAdd(chk + 2 * k, d * d); atomicAdd(chk + 2 * k + 1, ref * ref); } }
__device__ __forceinline__ float proj_ref(const Args& a, int t, int col, int lane) {
    const float* x = a.in[0] + (size_t)t * DM; float ss = 0.f;
    for (int j = lane; j < DM; j += 64) ss += x[j] * x[j];
    ss = wave_sum(ss); const float rstd = rsqrtf(ss * (1.f / DM) + NORM_EPS);
    float acc = 0.f;
    for (int j = lane; j < DM; j += 64) acc += x[j] * rstd * a.in[1][j] * a.in[2][(size_t)j * INW + col];
    return wave_sum(acc);
}
__device__ __forceinline__ void chk_proj(const Args& a, float* chk, int si, int lane, const bf16_t* as5, const bf16_t* nat) {
    const unsigned hsh = hash_u(si * 2 + 1); const int t = hsh % MTOK, col = (hsh >> 14) % INW;
    const float ref = proj_ref(a, t, col, lane); float opt;
    if (col < 512) { const int g = col >> 4, p = col & 15; opt = bf2f(as5[((size_t)(g * 1024 + (t >> 4))) * 384 + (t & 15) * 16 + p]); }
    else opt = bf2f(nat[(size_t)t * NATW + col - 512]);
    chk_add(chk, 1, opt, ref, lane);
}
__device__ __forceinline__ void chk_s5(const Args& a, float* chk, int si, int lane, const bf16_t* as5, const bf16_t* yg) {
    const unsigned hsh = hash_u(si * 2 + 77); const int b = hsh & 1, g = (hsh >> 1) & 31; int t = (hsh >> 6) % SEQ; if ((si & 3) == 0) t &= 63; if ((si & 3) == 1) t &= 1023;
    const int n = lane;
    const double dt = exp((double)a.in[10][g]);
    const double lr = (double)fminf(a.in[3][g * 64 + n], -1e-4f), li = (double)a.in[4][g * 64 + n];
    double are, aim; s5_pow(lr, li, dt, 1.0, are, aim);
    const double den = lr * lr + li * li, nr = are - 1.0;
    const double cr = (nr * lr + aim * li) / den, ci = (aim * lr - nr * li) / den;
    double bbr[16], bbi[16];
#pragma unroll
    for (int p = 0; p < 16; ++p) { const double br = (double)a.in[5][(g * 64 + n) * 16 + p], bi = (double)a.in[6][(g * 64 + n) * 16 + p]; bbr[p] = cr * br - ci * bi; bbi[p] = cr * bi + ci * br; }
    double hr = 0.0, hi = 0.0;
    for (int s = 0; s <= t; ++s) {
        const int tg = b * SEQ + s; const bf16_t* up = as5 + ((size_t)(g * 1024 + (tg >> 4))) * 384 + (tg & 15) * 16;
        const u32x4 w0 = *(const u32x4*)up, w1 = *(const u32x4*)(up + 8);
        float uf[16]; uf[0] = bflo(w0.x); uf[1] = bfhi(w0.x); uf[2] = bflo(w0.y); uf[3] = bfhi(w0.y); uf[4] = bflo(w0.z); uf[5] = bfhi(w0.z); uf[6] = bflo(w0.w); uf[7] = bfhi(w0.w);
        uf[8] = bflo(w1.x); uf[9] = bfhi(w1.x); uf[10] = bflo(w1.y); uf[11] = bfhi(w1.y); uf[12] = bflo(w1.z); uf[13] = bfhi(w1.z); uf[14] = bflo(w1.w); uf[15] = bfhi(w1.w);
        double br = 0.0, bi = 0.0;
#pragma unroll
        for (int p = 0; p < 16; ++p) { br += bbr[p] * (double)uf[p]; bi += bbi[p] * (double)uf[p]; }
        const double nhr = are * hr - aim * hi + br, nhi = are * hi + aim * hr + bi; hr = nhr; hi = nhi;
    }
    const int tg = b * SEQ + t;
    for (int p = 0; p < 16; ++p) {
        float y = (float)(hr * (double)a.in[7][(g * 16 + p) * 64 + n] - hi * (double)a.in[8][(g * 16 + p) * 64 + n]);
        y = wave_sum(y);
        y += a.in[9][g * 16 + p] * bf2f(as5[((size_t)(g * 1024 + (tg >> 4))) * 384 + (tg & 15) * 16 + p]);
        chk_add(chk, 2, bf2f(yg[(size_t)tg * 512 + g * 16 + p]), gelu_tanh(y), lane);
    }
}
__device__ __forceinline__ void chk_hgrn(const Args& a, float* chk, int si, int lane, const bf16_t* nat, const bf16_t* yb) {
    const unsigned hsh = hash_u(si * 2 + 1234567); const int b = hsh & 1, h = (hsh >> 1) & 3; int t = (hsh >> 4) % SEQ; if ((si & 3) == 0) t &= 255;
    const size_t rb = (size_t)b * SEQ;
    float q[2], D[2] = {1.f, 1.f}, o[2] = {0.f, 0.f}, lbv[2];
#pragma unroll
    for (int i = 0; i < 2; ++i) { const int k = lane + 64 * i; const float qq = bf2f(nat[(rb + t) * NATW + NC_Q + h * 128 + k]); q[i] = qq / (1.f + expf(-qq)); lbv[i] = hgrn_lb(a.in[13], h * 128 + k); }
    const int s_lo = t > 1023 ? t - 1023 : 0;
    for (int s = t; s >= s_lo; --s) {
        const bf16_t* r = nat + (rb + s) * NATW + h * 128; float w = 0.f, fg[2];
#pragma unroll
        for (int i = 0; i < 2; ++i) { const int k = lane + 64 * i; const float f = bf2f(r[NC_F + k]); fg[i] = lbv[i] + (1.f - lbv[i]) / (1.f + expf(-f)); w += q[i] * (1.f - fg[i]) * D[i]; }
        w = wave_sum(w);
#pragma unroll
        for (int i = 0; i < 2; ++i) { o[i] += w * bf2f(r[NC_I + lane + 64 * i]); D[i] *= fg[i]; }
    }
    float ss = 0.f;
#pragma unroll
    for (int i = 0; i < 2; ++i) { const float og = bf2f(nat[(rb + t) * NATW + NC_OG + h * 128 + lane + 64 * i]); o[i] = o[i] / (1.f + expf(-og)); ss += o[i] * o[i]; }
    ss = wave_sum(ss); const float rs = rsqrtf(ss * (1.f / 128.f) + NORM_EPS);
#pragma unroll
    for (int i = 0; i < 2; ++i) { const int vc = h * 128 + lane + 64 * i; const float zb = bf2f(nat[(rb + t) * NATW + NC_ZB + vc]); const float ref = o[i] * rs * a.in[14][vc] * (zb / (1.f + expf(-zb)));
        const float opt = bf2f(yb[(rb + t) * 512 + vc]); const float d = opt - ref; float n2 = wave_sum(d * d), r2 = wave_sum(ref * ref);
        if (lane == 0) { atomicAdd(chk + 6, n2); atomicAdd(chk + 7, r2); } }
}
__device__ __forceinline__ void chk_glu(const Args& a, float* chk, int si, int lane, const bf16_t* yg, const bf16_t* nat, const bf16_t* ya) {
    const unsigned hsh = hash_u(si * 2 + 999); const int t = hsh % MTOK, col = (hsh >> 14) & 511; float v = 0.f;
    for (int k = lane; k < 512; k += 64) v += bf2f(yg[(size_t)t * 512 + k]) * a.in[11][(size_t)k * 512 + col];
    v = wave_sum(v) + a.in[12][col];
    const float za = bf2f(nat[(size_t)t * NATW + NC_ZA + col]);
    const float ref = bf2f(yg[(size_t)t * 512 + col]) / (1.f + expf(-v)) * (za / (1.f + expf(-za)));
    chk_add(chk, 4, bf2f(ya[(size_t)t * 512 + col]), ref, lane);
}
__device__ __forceinline__ void chk_merge(const Args& a, float* chk, int si, int lane, const bf16_t* ya, const bf16_t* yb, const bf16_t* nat) {
    const unsigned hsh = hash_u(si * 2 + 31337); const int t = hsh % MTOK, n = (hsh >> 14) & 1023; float s1 = 0.f, s2 = 0.f;
    for (int k = lane; k < 512; k += 64) { s1 += bf2f(ya[(size_t)t * 512 + k]) * a.in[15][(size_t)k * DM + n]; s2 += bf2f(yb[(size_t)t * 512 + k]) * a.in[16][(size_t)k * DM + n]; }
    s1 = wave_sum(s1); s2 = wave_sum(s2);
    const float ga = bf2f(nat[(size_t)t * NATW + NC_GA + n]), gb = proj_ref(a, t, 512 + NC_GB + n, lane);
    const float ref = s1 / (1.f + expf(-ga)) + s2 / (1.f + expf(-gb));
    chk_add(chk, 5, bf2f(nat[(size_t)t * NATW + NC_GB + n]), ref, lane);
}
#endif


#define XB_TMO      128
#define XB_XCNT(j)  (256  + 64 * (j))
#define XB_XSUB(j)  (1280 + 64 * (j))
#define XB_XGEN(j)  (2304 + 64 * (j))
#define XB_TOP      3328
#define XB_TOPGEN   3392
#define XCD_BAR_WORDS 3456
#define XB_SPIN_CAP (1u << 22)
__device__ __forceinline__ unsigned xb_ld(unsigned* p)              { return __hip_atomic_load(p, __ATOMIC_RELAXED, __HIP_MEMORY_SCOPE_AGENT); }
__device__ __forceinline__ unsigned xb_add(unsigned* p, unsigned v) { return __hip_atomic_fetch_add(p, v, __ATOMIC_RELAXED, __HIP_MEMORY_SCOPE_AGENT); }
__device__ __forceinline__ unsigned xb_xcc_id() { return (unsigned)__builtin_amdgcn_s_getreg((3 << 11) | 20) & 0xFu; }
#define XB_SPIN(cond, bar) do { unsigned _sp = 0; while (cond) { __builtin_amdgcn_s_sleep(1); \
    if ((++_sp & 255u) == 0u) { if (xb_ld(&(bar)[XB_TMO])) break; if (_sp > XB_SPIN_CAP) { atomicAdd(&(bar)[XB_TMO], 1u); break; } } } } while (0)
struct XcdBarrier { unsigned* bar; unsigned x; volatile LAS unsigned* st; };
__device__ __forceinline__ XcdBarrier xcd_barrier_post(unsigned* bar, volatile LAS unsigned* st) {
    XcdBarrier b; b.bar = bar; b.x = xb_xcc_id(); b.st = st;
    if (threadIdx.x == 0) (void)xb_add(&bar[XB_XCNT(b.x)], 1u);
    return b;
}
__device__ __forceinline__ void xcd_barrier_complete(unsigned* bar, unsigned x, unsigned& nloc, unsigned& nx) {
    const unsigned G = gridDim.x * gridDim.y * gridDim.z;
    unsigned sum, cnt, mine, sp = 0u;
    for (;;) {
        sum = 0u; cnt = 0u; mine = 0u;
#pragma unroll
        for (unsigned j = 0; j < 16; ++j) { const unsigned c = xb_ld(&bar[XB_XCNT(j)]); sum += c; cnt += (c > 0u) ? 1u : 0u; mine = (j == x) ? c : mine; }
        if (sum == G) break;
        __builtin_amdgcn_s_sleep(1);
        if ((++sp & 255u) == 0u) { if (xb_ld(&bar[XB_TMO])) break; if (sp > XB_SPIN_CAP) { atomicAdd(&bar[XB_TMO], 1u); break; } }
    }
    nloc = mine > 0u ? mine : 1u; nx = cnt > 0u ? cnt : 1u;
}
__device__ __forceinline__ void xcd_barrier(const XcdBarrier& b) {
    asm volatile("s_waitcnt vmcnt(0)" ::: "memory");
    __syncthreads();
    if (threadIdx.x == 0) {
        unsigned* bar = b.bar;
        __builtin_amdgcn_s_waitcnt(0);
        unsigned nloc = b.st[0], nx = b.st[1];
        if (nloc == 0u) { xcd_barrier_complete(bar, b.x, nloc, nx); b.st[0] = nloc; b.st[1] = nx; }
        const unsigned old = xb_add(&bar[XB_XSUB(b.x)], 1u);
        const unsigned gen = old / nloc;
        if (old + 1u == (gen + 1u) * nloc) {
            __builtin_amdgcn_fence(__ATOMIC_RELEASE, "agent");
            asm volatile("s_waitcnt vmcnt(0)" ::: "memory");
            const unsigned og = xb_add(&bar[XB_TOP], 1u);
            const unsigned tg = og / nx;
            if (og + 1u == (tg + 1u) * nx) xb_add(&bar[XB_TOPGEN], 1u);
            else XB_SPIN(xb_ld(&bar[XB_TOPGEN]) == tg, bar);
            __builtin_amdgcn_fence(__ATOMIC_ACQUIRE, "agent");
            xb_add(&bar[XB_XGEN(b.x)], 1u);
            asm volatile("s_waitcnt vmcnt(0)" ::: "memory");
        } else {
            XB_SPIN(xb_ld(&bar[XB_XGEN(b.x)]) == gen, bar);
            __builtin_amdgcn_fence(__ATOMIC_ACQUIRE, "agent");
            asm volatile("s_waitcnt vmcnt(0)" ::: "memory");
        }
    }
    __syncthreads();
}

constexpr int LDS_BYTES = 147456;
__global__ void __launch_bounds__(512, 2) mega(Args a) {
    extern __shared__ __attribute__((aligned(16))) unsigned char lds_raw[];
    LAS unsigned char* lds = (LAS unsigned char*)lds_raw;
    cg::grid_group grid = cg::this_grid();
    const int tid = threadIdx.x, lane = tid & 63, wave = __builtin_amdgcn_readfirstlane(tid >> 6);
    const int G = gridDim.x, bx = blockIdx.x;
    const int gw = bx * 8 + wave, NGW = G * 8;
    unsigned char* ws = a.ws;
    float* chk = (float*)(ws + WS_CTL);
    volatile LAS unsigned* bst = (volatile LAS unsigned*)(lds + 140000);
    if (tid < 2) bst[tid] = 0u;
    __syncthreads();
    XcdBarrier xbar = xcd_barrier_post((unsigned*)(ws + WS_CTL) + 1024, bst);
    if (gridDim.x == 0x7fffffffu) grid.sync();
#define GRID_BAR() xcd_barrier(xbar)
    bf16_t* Win_t = (bf16_t*)(ws + WS_WIN); bf16_t* Wglu_t = (bf16_t*)(ws + WS_WGLU); bf16_t* Wpa_t = (bf16_t*)(ws + WS_WPA); bf16_t* Wpb_t = (bf16_t*)(ws + WS_WPB); bf16_t* Wout_t = (bf16_t*)(ws + WS_WOUT);
    bf16_t* TQ = (bf16_t*)(ws + WS_TQ); bf16_t* PP = (bf16_t*)(ws + WS_PP); float* misc = (float*)(ws + WS_MISC); float* rowss = (float*)(ws + WS_ROWSS);
    bf16_t* as5 = (bf16_t*)(ws + WS_AS5); bf16_t* ya = (bf16_t*)(ws + WS_AS5); bf16_t* yg = (bf16_t*)(ws + WS_YG); bf16_t* yb = (bf16_t*)(ws + WS_YB); bf16_t* nat = (bf16_t*)(ws + WS_NAT);
    unsigned char* ob = (unsigned char*)a.out;
    bf16_t* xn = (bf16_t*)(ob + DO_XN); bf16_t* Ut = (bf16_t*)(ob + DO_US); float* hloc = (float*)(ob + DO_HLOC); float* dec = (float*)(ob + DO_DEC);

    REP(0) if (PH(0)) {
        if (bx < 32) s5_build(a, bx, lds, tid, TQ, PP, misc);
        LAS float* scr = (LAS float*)(lds + wave * 16384);
        constexpr int I_IN = (DM / 64) * (INW / 32), I_GLU = (512 / 64) * (512 / 32), I_PA = (512 / 64) * (DM / 32), I_OUT = (DM / 64) * (DM / 32);
        constexpr int NITEMS = I_IN + I_GLU + 2 * I_PA + I_OUT;
        for (int it = gw; it < NITEMS; it += NGW) {
            int r = it;
            if (r < I_IN) { p0_transpose_item(a.in[2], DM, INW, Win_t, a.in[1], scr, r, lane); continue; } r -= I_IN;
            if (r < I_GLU) { p0_transpose_item(a.in[11], 512, 512, Wglu_t, nullptr, scr, r, lane); continue; } r -= I_GLU;
            if (r < I_PA) { p0_transpose_item(a.in[15], 512, DM, Wpa_t, nullptr, scr, r, lane); continue; } r -= I_PA;
            if (r < I_PA) { p0_transpose_item(a.in[16], 512, DM, Wpb_t, nullptr, scr, r, lane); continue; } r -= I_PA;
            p0_transpose_item(a.in[17], DM, DM, Wout_t, nullptr, scr, r, lane);
        }
        for (int m = gw; m < MTOK; m += NGW) {
            const f32x4* xr = (const f32x4*)(a.in[0] + (size_t)m * DM) + lane;
            f32x4 v[4]; float s = 0.f;
#pragma unroll
            for (int j = 0; j < 4; ++j) { v[j] = xr[64 * j]; s += (v[j].x * v[j].x + v[j].y * v[j].y) + (v[j].z * v[j].z + v[j].w * v[j].w); }
            const float rstd = rsqrtf(wave_sum(s) * (1.f / DM) + NORM_EPS);
            u32x2* o8 = (u32x2*)(xn + (size_t)m * DM) + lane;
#pragma unroll
            for (int j = 0; j < 4; ++j) { u32x2 o; o.x = pk2(v[j].x * rstd, v[j].y * rstd); o.y = pk2(v[j].z * rstd, v[j].w * rstd); o8[64 * j] = o; }
        }
    }
    GRID_BAR();
    if (PROBE_REP == 9) { for (int r_ = 0; r_ < 8; ++r_) GRID_BAR(); }
    REP(1) if (PH(1)) {
        pg8::Gemm g{xn, Win_t, DM, DM, DM}; pg8::StaticOrder S; S.init(MTOK, INW, G, bx);
        pg8::EpiG1 E{as5, nat};
        pg8::gemm_phase<pg8::EpiG1, pg8::StaticOrder>(lds, g, S, E);
    }
    GRID_BAR();
#if DBG_CHECK
    for (int si = gw; si < 4096; si += NGW) chk_proj(a, chk, si, lane, as5, nat);
#endif
    REP(2) if (PH(2)) {
        pg8::Gemm g{as5, PP, 384, 256, 256}; pg8::S5Order S{G, bx};
        pg8::EpiHloc E{hloc};
        pg8::gemm_phase<pg8::EpiHloc, pg8::S5Order>(lds, g, S, E);
        for (int it = bx; it < 1024; it += G) hgrn_h1(a, lds, it, tid, nat, Ut, dec);
    }
    GRID_BAR();
    if (PH(3)) {
        if (G > 64) {
            REP(3) for (int it = bx; it < 64; it += G) s5_carry(lds, it, tid, hloc, as5, misc);
            if (bx >= 64) for (int e = (bx - 64) * 512 + tid; e < 65536; e += (G - 64) * 512) hgrn_h2(e, Ut, dec);
        } else {
            for (int it = bx; it < 64; it += G) s5_carry(lds, it, tid, hloc, as5, misc);
            for (int e = bx * 512 + tid; e < 65536; e += G * 512) hgrn_h2(e, Ut, dec);
        }
    }
    GRID_BAR();
    REP(4) if (PH(4)) {
        pg8::Gemm g{as5, TQ, 384, 384, 384}; pg8::S5Order S{G, bx};
        pg8::EpiYg E{yg};
        pg8::gemm_phase<pg8::EpiYg, pg8::S5Order>(lds, g, S, E);
        for (int it = bx; it < 1024; it += G) hgrn_h3(a, lds, it, tid, nat, Ut, yb);
    }
    GRID_BAR();
#if DBG_CHECK
    for (int si = gw; si < 2048; si += NGW) chk_s5(a, chk, si, lane, as5, yg);
    for (int si = gw; si < 2048; si += NGW) chk_hgrn(a, chk, si, lane, nat, yb);
    GRID_BAR();
#endif
    REP(5) if (PH(5)) {
        pg8::Gemm g{yg, Wglu_t, 512, 512, 512}; pg8::StaticOrder S; S.init(MTOK, 512, G, bx);
        pg8::EpiGlu E{yg, nat, a.in[12], ya};
        pg8::gemm_phase<pg8::EpiGlu, pg8::StaticOrder>(lds, g, S, E);
    }
    GRID_BAR();
#if DBG_CHECK
    for (int si = gw; si < 4096; si += NGW) chk_glu(a, chk, si, lane, yg, nat, ya);
#endif
    if (PH(6)) {
        pg8::StaticOrder S; S.init(MTOK, DM, G, bx);
        REP(6) { pg8::Gemm g{ya, Wpa_t, 512, 512, 512}; pg8::EpiM1 E{nat, a.out}; pg8::gemm_phase<pg8::EpiM1, pg8::StaticOrder>(lds, g, S, E); }
        { pg8::Gemm g{yb, Wpb_t, 512, 512, 512}; pg8::EpiM2 E{nat, a.out}; pg8::gemm_phase<pg8::EpiM2, pg8::StaticOrder>(lds, g, S, E); }
    }
    GRID_BAR();
#if DBG_CHECK
    for (int si = gw; si < 4096; si += NGW) chk_merge(a, chk, si, lane, ya, yb, nat);
#endif
    REP(7) if (PH(7)) {
        pg8::Gemm g{nat + NC_GB, Wout_t, NATW, DM, DM}; pg8::StaticOrder S; S.init(MTOK, DM, G, bx);
        pg8::EpiOut E{a.in[0], a.out, rowss};
        pg8::gemm_phase<pg8::EpiOut, pg8::StaticOrder>(lds, g, S, E);
    }
    GRID_BAR();
    if (PH(8)) for (int m = gw; m < MTOK; m += NGW) {
        f32x4* hr = (f32x4*)(a.out + (size_t)m * DM) + lane;
        float tot = 0.f;
        { const float pv = (lane < 16) ? rowss[(size_t)m * 16 + lane] : 0.f; tot = wave_sum(pv); }
        const float rs = rsqrtf(tot * (1.f / DM) + NORM_EPS);
        const f32x4* fw = (const f32x4*)a.in[18] + lane;
#pragma unroll
        for (int j = 0; j < 4; ++j) { f32x4 v = hr[64 * j]; const f32x4 w = fw[64 * j]; v = v * rs * w; hr[64 * j] = v; }
    }
#if DBG_CHECK
    GRID_BAR();
    if (bx == 0 && tid == 0) {
        for (int k = 1; k <= 5; ++k) {
            const float num = chk[2 * k], den = chk[2 * k + 1]; const float err = sqrtf(num / (den + 1e-30f));
            if (!(err <= 0.03f)) { float e = err; if (!(e <= 0.9f)) e = 0.9f; a.out[0] += (float)(1 << (k + 2)) * (1.f + e); break; }
        }
    }
#endif
}

extern "C" void kernel_launch(void* const* d_in, const int* in_sizes, int n_in, void* d_out, int out_size, void* d_ws, size_t ws_size, hipStream_t stream) {
    static int grid = 0;
    if (grid == 0) {
        int dev = 0, cus = 0, per_cu = 0;
        hipGetDevice(&dev);
        hipDeviceGetAttribute(&cus, hipDeviceAttributeMultiprocessorCount, dev);
        if (hipFuncSetAttribute((const void*)mega, hipFuncAttributeMaxDynamicSharedMemorySize, LDS_BYTES) != hipSuccess) fprintf(stderr, "hipFuncSetAttribute failed\n");
        if (hipOccupancyMaxActiveBlocksPerMultiprocessor(&per_cu, (const void*)mega, 512, LDS_BYTES) != hipSuccess || per_cu < 1) { fprintf(stderr, "occupancy query: %d\n", per_cu); per_cu = 1; }
        (void)hipGetLastError();
        grid = cus * 1;
        if (n_in != 19 || ws_size < WS_END) fprintf(stderr, "kernel_launch: unexpected n_in %d / ws %zu\n", n_in, ws_size);
    }
    (void)hipMemsetAsync((char*)d_ws + WS_CTL, 0, 32768, stream);
    Args a{};
    for (int i = 0; i < 19; ++i) a.in[i] = (const float*)d_in[i];
    a.out = (float*)d_out; a.ws = (unsigned char*)d_ws;
    void* args[] = {&a};
    hipError_t e = hipLaunchCooperativeKernel((const void*)mega, dim3(grid), dim3(512), args, LDS_BYTES, stream);
    if (e != hipSuccess) fprintf(stderr, "cooperative launch failed: %s (grid %d)\n", hipGetErrorString(e), grid);
}
```

```cpp
#include <hip/hip_runtime.h>
#include <hip/hip_cooperative_groups.h>
#include <cstdio>
#include <cstdint>
namespace cg = cooperative_groups;

#ifndef DBG_CHECK
#define DBG_CHECK 0
#endif
#ifndef PHASES
#define PHASES 0x1ff
#endif
#define PH(k) (((PHASES) >> (k)) & 1)
#ifndef PROBE_REP
#define PROBE_REP -1
#endif
#define REP(k) for (int rep_ = 0; rep_ < ((PROBE_REP == (k)) ? 2 : 1); ++rep_)

#define LAS __attribute__((address_space(3)))
typedef unsigned short bf16_t;
typedef short bf16x8 __attribute__((ext_vector_type(8)));
typedef float f32x4 __attribute__((ext_vector_type(4)));
typedef unsigned u32x4 __attribute__((ext_vector_type(4)));
typedef unsigned u32x2 __attribute__((ext_vector_type(2)));

constexpr int SEQ = 8192, DM = 1024, MTOK = 16384;
constexpr int INW = 5632, NATW = 5120;
constexpr float NORM_EPS = 1e-6f;
constexpr int NC_ZA = 0, NC_Q = 512, NC_F = 1024, NC_I = 1536, NC_OG = 2048, NC_ZB = 2560, NC_GA = 3072, NC_GB = 4096;

constexpr size_t MiB = 1u << 20;
constexpr size_t WS_CTL = 0;
constexpr size_t WS_WIN = 1 * MiB, WS_WGLU = 12 * MiB, WS_WPA = 13 * MiB, WS_WPB = 14 * MiB, WS_WOUT = 15 * MiB;
constexpr size_t WS_TQ = 17 * MiB, WS_PP = 23 * MiB, WS_MISC = 27 * MiB, WS_ROWSS = 28 * MiB;
constexpr size_t WS_AS5 = 29 * MiB, WS_YG = 53 * MiB, WS_YB = 69 * MiB, WS_NAT = 85 * MiB, WS_END = 245 * MiB;
constexpr size_t DO_XN = 0, DO_US = 0, DO_HLOC = 32 * MiB, DO_DEC = 48 * MiB;

__device__ __forceinline__ float bf2f(bf16_t h) { return __uint_as_float(((unsigned)h) << 16); }
__device__ __forceinline__ unsigned f2bf(float f) { unsigned u = __float_as_uint(f); return (u + 0x7fffu + ((u >> 16) & 1u)) >> 16; }
__device__ __forceinline__ unsigned pk2(float lo, float hi) { return f2bf(lo) | (f2bf(hi) << 16); }
__device__ __forceinline__ float bflo(unsigned w) { return __uint_as_float(w << 16); }
__device__ __forceinline__ float bfhi(unsigned w) { return __uint_as_float(w & 0xffff0000u); }
__device__ __forceinline__ float sigmoidf_(float x) { return __builtin_amdgcn_rcpf(1.f + __expf(-x)); }
__device__ __forceinline__ float siluf_(float x) { return x * sigmoidf_(x); }
__device__ __forceinline__ float gelu_tanh(float x) { const float u = 0.7978845608028654f * (x + 0.044715f * x * x * x); return x * sigmoidf_(2.f * u); }
__device__ __forceinline__ float wave_sum(float v) {
#pragma unroll
    for (int o = 1; o < 64; o <<= 1) v += __shfl_xor(v, o);
    return v;
}
#define LDS_WAIT() asm volatile("s_waitcnt lgkmcnt(0)" ::: "memory")
__device__ __forceinline__ int opaque_tid() { int t = threadIdx.x; asm volatile("" : "+v"(t)); return t; }

struct Args { const float* in[19]; float* out; unsigned char* ws; };

namespace pg8 {
constexpr int BM = 256, BK = 64, HALF = 128, HTB = HALF * BK * 2, STAGE_BYTES = 8 * HTB, NXCD = 8, WGM = 8;
__host__ __device__ __forceinline__ int lds_byte(int r, int c) { const int st = (r >> 4) * 2 + (c >> 5), rr = r & 15, cc = c & 31, ob = rr * 64 + cc * 2; return st * 1024 + (ob ^ (((ob >> 9) & 1) << 5)); }
__host__ __device__ __forceinline__ void stage_rc(int b, int& R, int& C) { const int st = b / 1024, sb = b % 1024, swz = sb ^ (((sb >> 9) & 1) << 5); R = (st >> 1) * 16 + swz / 64; C = (st & 1) * 32 + (swz % 64) / 2; }
__host__ __device__ __forceinline__ int perm32(int rho) { const int n = rho >> 4, i = rho & 15; return 8 * (i >> 2) + 4 * n + (i & 3); }

struct Unit { int pm, pn; };
struct Gemm { const bf16_t* A; const bf16_t* Bt; int lda, ldb, K; };

struct StaticOrder {
    int nM, nN, nwg, G, c;
    __device__ void init(int M, int N, int G_, int c_) { nM = M / BM; nN = N / BM; nwg = nM * nN; G = G_; c = c_; }
    __device__ bool next(int i, Unit& u) const {
        const long L = (long)i * G + c; if (L >= nwg) return false;
        int wgid = (int)L; { const int q = nwg / NXCD, r = nwg % NXCD, xcd = wgid % NXCD, off = wgid / NXCD; wgid = (xcd < r ? xcd * (q + 1) : r * (q + 1) + (xcd - r) * q) + off; }
        const int nig = WGM * nN, gid = wgid / nig, fm = gid * WGM, gsz = (nM - fm) < WGM ? (nM - fm) : WGM;
        u.pm = fm + ((wgid % nig) % gsz); u.pn = (wgid % nig) / gsz; return true;
    }
};
struct S5Order {
    int G, c;
    __device__ bool next(int i, Unit& u) const { const int L = i * G + c; if (L >= 128) return false; u.pm = L; u.pn = L >> 2; return true; }
};

__device__ __forceinline__ unsigned cvt_pk_bf16(float lo, float hi) { unsigned r; asm volatile("v_cvt_pk_bf16_f32 %0, %1, %2" : "=v"(r) : "v"(lo), "v"(hi)); return r; }

#define EPI_LOOP_BEGIN  _Pragma("unroll") for (int ai = 0; ai < 2; ++ai) _Pragma("unroll") for (int m = 0; m < 4; ++m) { const int row = u.pm * BM + ai * HALF + wr * 64 + m * 16 + fr; _Pragma("unroll") for (int bj = 0; bj < 2; ++bj) { const int lc = bj * HALF + wc * 32 + 8 * fq; const f32x4 v0 = acc[ai][bj][m][0], v1 = acc[ai][bj][m][1];
#define EPI_LOOP_END } }

struct EpiG1 {
    static constexpr bool PERM = true;
    bf16_t* as5; bf16_t* nat;
    __device__ __forceinline__ void operator()(const f32x4 (&acc)[2][2][4][2], const Unit& u, int wr, int wc, int fr, int fq) const {
        EPI_LOOP_BEGIN
            u32x4 w; w.x = cvt_pk_bf16(v0[0], v0[1]); w.y = cvt_pk_bf16(v0[2], v0[3]); w.z = cvt_pk_bf16(v1[0], v1[1]); w.w = cvt_pk_bf16(v1[2], v1[3]);
            if (u.pn < 2) {
                const int col = u.pn * BM + lc, g = col >> 4, p0 = col & 15, chunk = row >> 4, s = row & 15;
                *(u32x4*)(as5 + ((size_t)(g * 1024 + chunk)) * 384 + s * 16 + p0) = w;
            } else {
                *(u32x4*)(nat + (size_t)row * NATW + (u.pn * BM - 512 + lc)) = w;
            }
        EPI_LOOP_END
    }
};
struct EpiHloc {
    static constexpr bool PERM = true;
    float* hloc;
    __device__ __forceinline__ void operator()(const f32x4 (&acc)[2][2][4][2], const Unit& u, int wr, int wc, int fr, int fq) const {
        EPI_LOOP_BEGIN
            if (bj == 0) { float* p = hloc + (size_t)row * 128 + lc; *(f32x4*)p = v0; *(f32x4*)(p + 4) = v1; }
        EPI_LOOP_END
    }
};
struct EpiYg {
    static constexpr bool PERM = true;
    bf16_t* yg;
    __device__ __forceinline__ void operator()(const f32x4 (&acc)[2][2][4][2], const Unit& u, int wr, int wc, int fr, int fq) const {
        const int g = u.pn;
        EPI_LOOP_BEGIN
            const int chunk = row - g * 1024, j = lc >> 4, p0 = lc & 15;
            u32x4 w; w.x = cvt_pk_bf16(gelu_tanh(v0[0]), gelu_tanh(v0[1])); w.y = cvt_pk_bf16(gelu_tanh(v0[2]), gelu_tanh(v0[3]));
            w.z = cvt_pk_bf16(gelu_tanh(v1[0]), gelu_tanh(v1[1])); w.w = cvt_pk_bf16(gelu_tanh(v1[2]), gelu_tanh(v1[3]));
            *(u32x4*)(yg + ((size_t)(chunk * 16 + j)) * 512 + g * 16 + p0) = w;
        EPI_LOOP_END
    }
};
struct EpiGlu {
    static constexpr bool PERM = true;
    const bf16_t* yg; const bf16_t* nat; const float* bias; bf16_t* ya;
    __device__ __forceinline__ void operator()(const f32x4 (&acc)[2][2][4][2], const Unit& u, int wr, int wc, int fr, int fq) const {
        EPI_LOOP_BEGIN
            const int col = u.pn * BM + lc;
            const f32x4 b0 = *(const f32x4*)(bias + col), b1 = *(const f32x4*)(bias + col + 4);
            const u32x4 y = *(const u32x4*)(yg + (size_t)row * 512 + col), z = *(const u32x4*)(nat + (size_t)row * NATW + NC_ZA + col);
            float o[8];
            o[0] = bflo(y.x) * sigmoidf_(v0[0] + b0[0]) * siluf_(bflo(z.x)); o[1] = bfhi(y.x) * sigmoidf_(v0[1] + b0[1]) * siluf_(bfhi(z.x));
            o[2] = bflo(y.y) * sigmoidf_(v0[2] + b0[2]) * siluf_(bflo(z.y)); o[3] = bfhi(y.y) * sigmoidf_(v0[3] + b0[3]) * siluf_(bfhi(z.y));
            o[4] = bflo(y.z) * sigmoidf_(v1[0] + b1[0]) * siluf_(bflo(z.z)); o[5] = bfhi(y.z) * sigmoidf_(v1[1] + b1[1]) * siluf_(bfhi(z.z));
            o[6] = bflo(y.w) * sigmoidf_(v1[2] + b1[2]) * siluf_(bflo(z.w)); o[7] = bfhi(y.w) * sigmoidf_(v1[3] + b1[3]) * siluf_(bfhi(z.w));
            u32x4 w; w.x = cvt_pk_bf16(o[0], o[1]); w.y = cvt_pk_bf16(o[2], o[3]); w.z = cvt_pk_bf16(o[4], o[5]); w.w = cvt_pk_bf16(o[6], o[7]);
            *(u32x4*)(ya + (size_t)row * 512 + col) = w;
        EPI_LOOP_END
    }
};
struct EpiM1 {
    static constexpr bool PERM = true;
    const bf16_t* nat; float* tmp;
    __device__ __forceinline__ void operator()(const f32x4 (&acc)[2][2][4][2], const Unit& u, int wr, int wc, int fr, int fq) const {
        EPI_LOOP_BEGIN
            const int col = u.pn * BM + lc;
            const u32x4 gq = *(const u32x4*)(nat + (size_t)row * NATW + NC_GA + col);
            f32x4 o0, o1;
            o0[0] = sigmoidf_(bflo(gq.x)) * v0[0]; o0[1] = sigmoidf_(bfhi(gq.x)) * v0[1]; o0[2] = sigmoidf_(bflo(gq.y)) * v0[2]; o0[3] = sigmoidf_(bfhi(gq.y)) * v0[3];
            o1[0] = sigmoidf_(bflo(gq.z)) * v1[0]; o1[1] = sigmoidf_(bfhi(gq.z)) * v1[1]; o1[2] = sigmoidf_(bflo(gq.w)) * v1[2]; o1[3] = sigmoidf_(bfhi(gq.w)) * v1[3];
            float* p = tmp + (size_t)row * DM + col; *(f32x4*)p = o0; *(f32x4*)(p + 4) = o1;
        EPI_LOOP_END
    }
};
struct EpiM2 {
    static constexpr bool PERM = true;
    bf16_t* nat; const float* tmp;
    __device__ __forceinline__ void operator()(const f32x4 (&acc)[2][2][4][2], const Unit& u, int wr, int wc, int fr, int fq) const {
        EPI_LOOP_BEGIN
            const int col = u.pn * BM + lc;
            bf16_t* gp = nat + (size_t)row * NATW + NC_GB + col;
            const u32x4 gq = *(const u32x4*)gp;
            const float* p = tmp + (size_t)row * DM + col; const f32x4 t0 = *(const f32x4*)p, t1 = *(const f32x4*)(p + 4);
            float o[8];
            o[0] = t0[0] + sigmoidf_(bflo(gq.x)) * v0[0]; o[1] = t0[1] + sigmoidf_(bfhi(gq.x)) * v0[1]; o[2] = t0[2] + sigmoidf_(bflo(gq.y)) * v0[2]; o[3] = t0[3] + sigmoidf_(bfhi(gq.y)) * v0[3];
            o[4] = t1[0] + sigmoidf_(bflo(gq.z)) * v1[0]; o[5] = t1[1] + sigmoidf_(bfhi(gq.z)) * v1[1]; o[6] = t1[2] + sigmoidf_(bflo(gq.w)) * v1[2]; o[7] = t1[3] + sigmoidf_(bfhi(gq.w)) * v1[3];
            u32x4 w; w.x = cvt_pk_bf16(o[0], o[1]); w.y = cvt_pk_bf16(o[2], o[3]); w.z = cvt_pk_bf16(o[4], o[5]); w.w = cvt_pk_bf16(o[6], o[7]);
            *(u32x4*)gp = w;
        EPI_LOOP_END
    }
};
struct EpiOut {
    static constexpr bool PERM = true;
    const float* x; float* out; float* rowss;
    __device__ __forceinline__ void operator()(const f32x4 (&acc)[2][2][4][2], const Unit& u, int wr, int wc, int fr, int fq) const {
#pragma unroll
        for (int ai = 0; ai < 2; ++ai)
#pragma unroll
            for (int m = 0; m < 4; ++m) {
                const int row = u.pm * BM + ai * HALF + wr * 64 + m * 16 + fr; float ss = 0.f;
#pragma unroll
                for (int bj = 0; bj < 2; ++bj) {
                    const int col = u.pn * BM + bj * HALF + wc * 32 + 8 * fq;
                    const float* xp = x + (size_t)row * DM + col; float* op = out + (size_t)row * DM + col;
                    const f32x4 h0 = *(const f32x4*)xp + acc[ai][bj][m][0], h1 = *(const f32x4*)(xp + 4) + acc[ai][bj][m][1];
                    *(f32x4*)op = h0; *(f32x4*)(op + 4) = h1;
                    ss += (h0[0] * h0[0] + h0[1] * h0[1]) + (h0[2] * h0[2] + h0[3] * h0[3]) + (h1[0] * h1[0] + h1[1] * h1[1]) + (h1[2] * h1[2] + h1[3] * h1[3]);
                }
                ss += __shfl_xor(ss, 16); ss += __shfl_xor(ss, 32);
                if (fq == 0) rowss[(size_t)row * 16 + u.pn * 4 + wc] = ss;
            }
    }
};

template <class Epi, class Sched, bool ALIGN_EPI = true, bool SP2 = true>
__device__ __forceinline__ void gemm_phase(LAS unsigned char* lds, const Gemm g, const Sched& S, const Epi& E) {
    const int tid = opaque_tid(), wid = __builtin_amdgcn_readfirstlane(tid >> 6), lane = tid & 63, wr = wid >> 2, wc = wid & 3, fr = lane & 15, fq = lane >> 4;
    const int K = g.K, nt = K / BK;
    unsigned voffA[2], voffB[2];
#pragma unroll
    for (int i = 0; i < 2; ++i) { int R, C; stage_rc(tid * 16 + i * 8192, R, C); const int Rb = Epi::PERM ? ((R & ~31) + perm32(R & 31)) : R;
        voffA[i] = (unsigned)(R * g.lda + C) * 2u; voffB[i] = (unsigned)(Rb * g.ldb + C) * 2u; }
    const size_t kstep = (size_t)(BK * 2);
    const size_t hstepA = (size_t)HALF * g.lda * 2, hstepB = (size_t)HALF * g.ldb * 2;
    const size_t tstepA = 2 * hstepA, tstepB = 2 * hstepB;
    const unsigned ldsw = (unsigned)wid * 1024u;
    const int aoff = lds_byte(wr * 64 + fr, fq * 8), boff = lds_byte(wc * 32 + fr, fq * 8);
#define PG8_SA(b, h) (((b) * 2 + (h)) * HTB)
#define PG8_SB(b, h) ((4 + (b) * 2 + (h)) * HTB)
#define PG8_STAGE(bufoff, gbase, voff) do { _Pragma("unroll") for (int _i = 0; _i < 2; ++_i) \
        __builtin_amdgcn_global_load_lds((const unsigned*)((const char*)(gbase) + (voff)[_i]), (LAS unsigned*)(lds + (bufoff) + ldsw + _i * 8192), 16, 0, 0); } while (0)
#define PG8_LDA(dst, b, h) do { _Pragma("unroll") for (int m = 0; m < 4; ++m) _Pragma("unroll") for (int k = 0; k < 2; ++k) dst[m][k] = *(const LAS bf16x8*)(lds + PG8_SA(b, h) + aoff + m * 2048 + k * 1024); } while (0)
#define PG8_LDB(dst, b, h) do { _Pragma("unroll") for (int n = 0; n < 2; ++n) _Pragma("unroll") for (int k = 0; k < 2; ++k) dst[n][k] = *(const LAS bf16x8*)(lds + PG8_SB(b, h) + boff + n * 2048 + k * 1024); } while (0)
#define PG8_MMA(ai, bj, At, Bt) do { __builtin_amdgcn_s_setprio(1); _Pragma("unroll") for (int m = 0; m < 4; ++m) _Pragma("unroll") for (int n = 0; n < 2; ++n) _Pragma("unroll") for (int k = 0; k < 2; ++k) \
        acc[ai][bj][m][n] = __builtin_amdgcn_mfma_f32_16x16x32_bf16(Bt[n][k], At[m][k], acc[ai][bj][m][n], 0, 0, 0); __builtin_amdgcn_s_setprio(0); } while (0)
#define PG8_WAIT_V(n) asm volatile("s_waitcnt vmcnt(" #n ")" ::: "memory")
#define PG8_WAIT_L(n) asm volatile("s_waitcnt lgkmcnt(" #n ")" ::: "memory")
#define PG8_BAR __builtin_amdgcn_s_barrier()
#define PG8_SCHED __builtin_amdgcn_sched_barrier(0)
    Unit cur, nxt; int ui = 0;
    if (!S.next(0, cur)) return;
    f32x4 acc[2][2][4][2];
#pragma unroll
    for (int a = 0; a < 2; ++a)
#pragma unroll
        for (int b = 0; b < 2; ++b)
#pragma unroll
            for (int m = 0; m < 4; ++m)
#pragma unroll
                for (int n = 0; n < 2; ++n) acc[a][b][m][n] = (f32x4){0.f, 0.f, 0.f, 0.f};
    bf16x8 At[4][2], B0[2][2], B1[2][2];
    const char* cA = (const char*)g.A + (size_t)cur.pm * tstepA; const char* cB = (const char*)g.Bt + (size_t)cur.pn * tstepB;
    if constexpr (SP2) {
        PG8_STAGE(PG8_SB(0, 0), cB, voffB); PG8_STAGE(PG8_SB(0, 1), cB + hstepB, voffB); PG8_STAGE(PG8_SA(0, 0), cA, voffA); PG8_STAGE(PG8_SA(0, 1), cA + hstepA, voffA);
        if (wr == 1) PG8_BAR;
        PG8_WAIT_V(2); PG8_BAR;
        PG8_STAGE(PG8_SB(1, 0), cB + kstep, voffB); PG8_STAGE(PG8_SA(1, 0), cA + kstep, voffA); PG8_STAGE(PG8_SB(1, 1), cB + hstepB + kstep, voffB);
        PG8_WAIT_V(6); PG8_BAR;
    } else {
        PG8_STAGE(PG8_SB(0, 0), cB, voffB); PG8_STAGE(PG8_SA(0, 0), cA, voffA); PG8_STAGE(PG8_SB(0, 1), cB + hstepB, voffB); PG8_STAGE(PG8_SA(0, 1), cA + hstepA, voffA);
        if (wr == 1) PG8_BAR;
        PG8_WAIT_V(4); PG8_BAR;
        PG8_STAGE(PG8_SB(1, 0), cB + kstep, voffB); PG8_STAGE(PG8_SA(1, 0), cA + kstep, voffA); PG8_STAGE(PG8_SB(1, 1), cB + hstepB + kstep, voffB);
        PG8_WAIT_V(6); PG8_BAR;
    }
    for (;;) {
        const bool has_next = S.next(ui + 1, nxt);
        const char* nA = has_next ? (const char*)g.A + (size_t)nxt.pm * tstepA : cA; const char* nB = has_next ? (const char*)g.Bt + (size_t)nxt.pn * tstepB : cB;
        for (int t = 0; t < nt; t += 2) {
            const bool last = (t == nt - 2);
            const char* a1 = cA + (size_t)(t + 1) * kstep;
            const char* a2 = last ? nA : cA + (size_t)(t + 2) * kstep; const char* b2 = last ? nB : cB + (size_t)(t + 2) * kstep;
            const char* a3 = a2 + kstep; const char* b3 = b2 + kstep;
            if constexpr (SP2) {
            PG8_LDB(B0, 0, 0); PG8_LDB(B1, 0, 1); PG8_SCHED; PG8_LDA(At, 0, 0); PG8_STAGE(PG8_SA(1, 1), a1 + hstepA, voffA);
            PG8_WAIT_V(8); PG8_WAIT_L(0); PG8_BAR; PG8_MMA(0, 0, At, B0); PG8_MMA(0, 1, At, B1); PG8_BAR; PG8_SCHED;
            PG8_LDA(At, 0, 1); PG8_STAGE(PG8_SB(0, 0), b2, voffB); PG8_STAGE(PG8_SB(0, 1), b2 + hstepB, voffB); PG8_STAGE(PG8_SA(0, 0), a2, voffA);
            PG8_WAIT_V(8); PG8_WAIT_L(0); PG8_BAR; PG8_MMA(1, 0, At, B0); PG8_MMA(1, 1, At, B1); PG8_BAR; PG8_SCHED;
            PG8_LDB(B0, 1, 0); PG8_LDB(B1, 1, 1); PG8_SCHED; PG8_LDA(At, 1, 0); PG8_STAGE(PG8_SA(0, 1), a2 + hstepA, voffA);
            PG8_WAIT_V(8); PG8_WAIT_L(0); PG8_BAR; PG8_MMA(0, 0, At, B0); PG8_MMA(0, 1, At, B1); PG8_BAR; PG8_SCHED;
            PG8_LDA(At, 1, 1); PG8_STAGE(PG8_SB(1, 0), b3, voffB); PG8_STAGE(PG8_SB(1, 1), b3 + hstepB, voffB); PG8_STAGE(PG8_SA(1, 0), a3, voffA);
            PG8_WAIT_V(8); PG8_WAIT_L(0); PG8_BAR; PG8_MMA(1, 0, At, B0); PG8_MMA(1, 1, At, B1); PG8_BAR; PG8_SCHED;
            } else {
            PG8_LDB(B0, 0, 0); PG8_SCHED; PG8_LDA(At, 0, 0); PG8_STAGE(PG8_SA(1, 1), a1 + hstepA, voffA);
            PG8_WAIT_L(8); PG8_BAR; PG8_WAIT_L(0); PG8_MMA(0, 0, At, B0); PG8_BAR; PG8_SCHED;
            PG8_LDB(B1, 0, 1); PG8_STAGE(PG8_SB(0, 0), b2, voffB);
            PG8_BAR; PG8_WAIT_L(0); PG8_MMA(0, 1, At, B1); PG8_BAR;
            PG8_LDA(At, 0, 1); PG8_STAGE(PG8_SA(0, 0), a2, voffA);
            PG8_BAR; PG8_WAIT_L(0); PG8_MMA(1, 0, At, B0); PG8_BAR; PG8_SCHED;
            PG8_STAGE(PG8_SB(0, 1), b2 + hstepB, voffB);
            PG8_WAIT_V(6); PG8_BAR; PG8_MMA(1, 1, At, B1); PG8_BAR;
            PG8_LDB(B0, 1, 0); PG8_SCHED; PG8_LDA(At, 1, 0); PG8_STAGE(PG8_SA(0, 1), a2 + hstepA, voffA);
            PG8_WAIT_L(8); PG8_BAR; PG8_WAIT_L(0); PG8_MMA(0, 0, At, B0); PG8_BAR; PG8_SCHED;
            PG8_LDB(B1, 1, 1); PG8_STAGE(PG8_SB(1, 0), b3, voffB);
            PG8_BAR; PG8_WAIT_L(0); PG8_MMA(0, 1, At, B1); PG8_BAR;
            PG8_LDA(At, 1, 1); PG8_STAGE(PG8_SA(1, 0), a3, voffA);
            PG8_BAR; PG8_WAIT_L(0); PG8_MMA(1, 0, At, B0); PG8_BAR; PG8_SCHED;
            PG8_STAGE(PG8_SB(1, 1), b3 + hstepB, voffB);
            PG8_WAIT_V(6); PG8_BAR; PG8_MMA(1, 1, At, B1); PG8_BAR;
            }
        }
        if constexpr (ALIGN_EPI) { if (wr == 0) PG8_BAR; }
        E(acc, cur, wr, wc, fr, fq);
        if (!has_next) break;
#pragma unroll
        for (int a = 0; a < 2; ++a)
#pragma unroll
            for (int b = 0; b < 2; ++b)
#pragma unroll
                for (int m = 0; m < 4; ++m)
#pragma unroll
                    for (int n = 0; n < 2; ++n) acc[a][b][m][n] = (f32x4){0.f, 0.f, 0.f, 0.f};
        cur = nxt; cA = nA; cB = nB; ++ui;
        if constexpr (ALIGN_EPI) { if (wr == 1) PG8_BAR; }
    }
    PG8_WAIT_V(0);
    if constexpr (!ALIGN_EPI) { if (wr == 0) PG8_BAR; }
    PG8_BAR;
#undef PG8_SA
#undef PG8_SB
#undef PG8_STAGE
#undef PG8_LDA
#undef PG8_LDB
#undef PG8_MMA
#undef PG8_WAIT_V
#undef PG8_WAIT_L
#undef PG8_BAR
#undef PG8_SCHED
}
}

__device__ __forceinline__ void p0_transpose_item(const float* W, int K, int N, bf16_t* WT, const float* scale, LAS float* scr, int item, int lane) {
    const int nblk = N / 32, kb = item / nblk, nb = item % nblk, k0 = 64 * kb, n0 = 32 * nb;
#pragma unroll 8
    for (int i = 0; i < 32; ++i) { const int kk = 2 * i + (lane >> 5); float v = W[(size_t)(k0 + kk) * N + n0 + (lane & 31)]; if (scale) v *= scale[k0 + kk]; scr[kk * 33 + (lane & 31)] = v; }
    LDS_WAIT(); asm volatile("" ::: "memory");
    const int c = lane & 7;
#pragma unroll
    for (int j = 0; j < 4; ++j) { const int n = (lane >> 3) + 8 * j; const LAS float* s = scr + (8 * c) * 33 + n;
        u32x4 o; o.x = pk2(s[0 * 33], s[1 * 33]); o.y = pk2(s[2 * 33], s[3 * 33]); o.z = pk2(s[4 * 33], s[5 * 33]); o.w = pk2(s[6 * 33], s[7 * 33]);
        *(u32x4*)(WT + (size_t)(n0 + n) * K + k0 + 8 * c) = o; }
    LDS_WAIT(); asm volatile("" ::: "memory");
}

__device__ __forceinline__ void sincos_d(double x, double& s, double& c) {
    const double k = rint(x * 0.6366197723675814);
    double r = fma(-k, 1.5707963267948966, x); r = fma(-k, 6.123233995736766e-17, r);
    const double r2 = r * r;
    double ps = 1.0 / 6227020800.0; ps = fma(ps, r2, -1.0 / 39916800.0); ps = fma(ps, r2, 1.0 / 362880.0); ps = fma(ps, r2, -1.0 / 5040.0); ps = fma(ps, r2, 1.0 / 120.0); ps = fma(ps, r2, -1.0 / 6.0); ps = fma(ps, r2, 1.0);
    const double sr = r * ps;
    double pc = -1.0 / 87178291200.0; pc = fma(pc, r2, 1.0 / 479001600.0); pc = fma(pc, r2, -1.0 / 3628800.0); pc = fma(pc, r2, 1.0 / 40320.0); pc = fma(pc, r2, -1.0 / 720.0); pc = fma(pc, r2, 1.0 / 24.0); pc = fma(pc, r2, -0.5); pc = fma(pc, r2, 1.0);
    const int q = (int)(((long long)k) & 3);
    s = (q == 0) ? sr : (q == 1) ? pc : (q == 2) ? -sr : -pc;
    c = (q == 0) ? pc : (q == 1) ? -sr : (q == 2) ? -pc : sr;
}
__device__ __forceinline__ void s5_pow(double lr, double li, double dt, double tau, double& re, double& im) {
    const double mag = exp(lr * dt * tau); double s, c; sincos_d(li * dt * tau, s, c); re = mag * c; im = mag * s;
}

__device__ __forceinline__ void s5_build(const Args& a, int g, LAS unsigned char* lds, int tid_, bf16_t* TQ, bf16_t* PP, float* misc) {
    const int tid = opaque_tid();
    LAS float* pwr = (LAS float*)lds;
    LAS float* pwi = pwr + 17 * 64;
    LAS float* bbr = pwi + 17 * 64;
    LAS float* bbi = bbr + 1024;
    LAS float* cre = bbi + 1024;
    LAS float* cim = cre + 1024;
    LAS float* Kt = cim + 1024;
    if (tid < 64) {
        const int n = tid;
        const double dt = exp((double)a.in[10][g]);
        const double lr = (double)fminf(a.in[3][g * 64 + n], -1e-4f), li = (double)a.in[4][g * 64 + n];
        double are = 1.0, aim = 0.0;
        for (int tau = 0; tau <= 16; ++tau) { double re, im; s5_pow(lr, li, dt, (double)tau, re, im); pwr[tau * 64 + n] = (float)re; pwi[tau * 64 + n] = (float)im; if (tau == 1) { are = re; aim = im; } }
        const double den = lr * lr + li * li, nr = are - 1.0;
        const double cr = (nr * lr + aim * li) / den, ci = (aim * lr - nr * li) / den;
        for (int p = 0; p < 16; ++p) { const double br = (double)a.in[5][(g * 64 + n) * 16 + p], bi = (double)a.in[6][(g * 64 + n) * 16 + p];
            bbr[n * 16 + p] = (float)(cr * br - ci * bi); bbi[n * 16 + p] = (float)(cr * bi + ci * br); }
        double r2, i2; s5_pow(lr, li, dt, 1024.0, r2, i2);
        float* mp = misc + (size_t)(g * 64 + n) * 4; mp[0] = pwr[16 * 64 + n]; mp[1] = pwi[16 * 64 + n]; mp[2] = (float)r2; mp[3] = (float)i2;
    }
    for (int e = tid; e < 1024; e += 512) { cre[e] = a.in[7][g * 1024 + e]; cim[e] = a.in[8][g * 1024 + e]; }
    __syncthreads();
    for (int e = tid; e < 4096; e += 512) {
        const int tau = e >> 8, p = (e >> 4) & 15, pp = e & 15; float s = 0.f;
        for (int n = 0; n < 64; ++n) { const float pr = pwr[tau * 64 + n], pi = pwi[tau * 64 + n], br = bbr[n * 16 + pp], bi = bbi[n * 16 + pp];
            const float wre = pr * br - pi * bi, wim = pr * bi + pi * br; s += cre[p * 64 + n] * wre - cim[p * 64 + n] * wim; }
        if (tau == 0 && p == pp) s += a.in[9][g * 16 + p];
        Kt[e] = s;
    }
    __syncthreads();
    for (int e = tid; e < 256 * 384; e += 512) {
        const int row = e / 384, col = e - row * 384, j = row >> 4, p = row & 15; float v;
        if (col < 256) { const int s = col >> 4, pp = col & 15; v = (s <= j) ? Kt[((j - s) * 16 + p) * 16 + pp] : 0.f; }
        else { const int nn = col - 256, n = nn & 63; const float ar = pwr[(j + 1) * 64 + n], ai = pwi[(j + 1) * 64 + n], cr = cre[p * 64 + n], ci = cim[p * 64 + n];
            v = (nn < 64) ? (cr * ar - ci * ai) : -(cr * ai + ci * ar); }
        TQ[(size_t)(g * 256 + row) * 384 + col] = (bf16_t)f2bf(v);
    }
    for (int e = tid; e < 256 * 256; e += 512) {
        const int row = e >> 8, col = e & 255; float v = 0.f;
        if (row < 128) { const int n = row & 63, s = col >> 4, pp = col & 15; const float pr = pwr[(15 - s) * 64 + n], pi = pwi[(15 - s) * 64 + n], br = bbr[n * 16 + pp], bi = bbi[n * 16 + pp];
            v = (row < 64) ? (pr * br - pi * bi) : (pr * bi + pi * br); }
        PP[(size_t)(g * 256 + row) * 256 + col] = (bf16_t)f2bf(v);
    }
    __syncthreads();
}

__device__ __forceinline__ float hgrn_lb(const float* lg, int w) { return 1.f / (1.f + expf(lg[512 + w] - lg[w])); }

__device__ __forceinline__ void hgrn_h1(const Args& a, LAS unsigned char* lds, int item, int tid_, const bf16_t* nat, bf16_t* Ut, float* dec) {
    const int tid = opaque_tid();
    const int bh = item >> 7, c = item & 127, b = bh >> 2, h = bh & 3;
    const size_t row0 = (size_t)b * SEQ + (size_t)c * 64;
    LAS bf16_t* KLT = (LAS bf16_t*)lds;
    LAS bf16_t* VT = KLT + 128 * 72;
    LAS float* SEGT = (LAS float*)(lds + 2 * 128 * 72 * 2);
    const int k = tid & 127, seg = tid >> 7, t0 = seg * 16;
    const bf16_t* base = nat + (row0 + t0) * NATW + h * 128 + k;
    bf16_t fraw[16], vraw[16];
#pragma unroll
    for (int i = 0; i < 16; ++i) { fraw[i] = base[(size_t)i * NATW + NC_F]; vraw[i] = base[(size_t)i * NATW + NC_I]; }
    const float lbv = hgrn_lb(a.in[13], h * 128 + k), olb = 1.f - lbv;
    float g[16], key[16], run = 0.f;
#pragma unroll
    for (int i = 0; i < 16; ++i) { const float f = fmaxf(bf2f(fraw[i]), -80.f); const float ef = __expf(-f); const float sg = __builtin_amdgcn_rcpf(1.f + ef);
        run += __logf(lbv + olb * sg); g[i] = run; key[i] = olb * ef * sg; }
    SEGT[seg * 128 + k] = run;
    { u32x4 w0, w1;
      w0.x = vraw[0] | ((unsigned)vraw[1] << 16); w0.y = vraw[2] | ((unsigned)vraw[3] << 16); w0.z = vraw[4] | ((unsigned)vraw[5] << 16); w0.w = vraw[6] | ((unsigned)vraw[7] << 16);
      w1.x = vraw[8] | ((unsigned)vraw[9] << 16); w1.y = vraw[10] | ((unsigned)vraw[11] << 16); w1.z = vraw[12] | ((unsigned)vraw[13] << 16); w1.w = vraw[14] | ((unsigned)vraw[15] << 16);
      *(LAS u32x4*)(VT + k * 72 + t0) = w0; *(LAS u32x4*)(VT + k * 72 + t0 + 8) = w1; }
    __syncthreads();
    { float off = 0.f, total = 0.f;
#pragma unroll
      for (int j = 0; j < 4; ++j) { const float sj = SEGT[j * 128 + k]; total += sj; if (j < seg) off += sj; }
      const float rem = total - off;
      unsigned pw[8];
#pragma unroll
      for (int i = 0; i < 8; ++i) pw[i] = pk2(key[2 * i] * __expf(rem - g[2 * i]), key[2 * i + 1] * __expf(rem - g[2 * i + 1]));
      u32x4 w0, w1; w0.x = pw[0]; w0.y = pw[1]; w0.z = pw[2]; w0.w = pw[3]; w1.x = pw[4]; w1.y = pw[5]; w1.z = pw[6]; w1.w = pw[7];
      *(LAS u32x4*)(KLT + k * 72 + t0) = w0; *(LAS u32x4*)(KLT + k * 72 + t0 + 8) = w1;
      if (seg == 0) dec[(size_t)item * 128 + k] = __expf(total); }
    __syncthreads();
    const int w = tid >> 6, lane = tid & 63, fr = lane & 15, fq = lane >> 4, k0 = 16 * w;
    const bf16x8 a0 = *(const LAS bf16x8*)(KLT + (k0 + fr) * 72 + fq * 8), a1 = *(const LAS bf16x8*)(KLT + (k0 + fr) * 72 + 32 + fq * 8);
#pragma unroll
    for (int vt = 0; vt < 8; ++vt) {
        const bf16x8 b0 = *(const LAS bf16x8*)(VT + (vt * 16 + fr) * 72 + fq * 8), b1 = *(const LAS bf16x8*)(VT + (vt * 16 + fr) * 72 + 32 + fq * 8);
        f32x4 acc = (f32x4){0.f, 0.f, 0.f, 0.f};
        acc = __builtin_amdgcn_mfma_f32_16x16x32_bf16(a0, b0, acc, 0, 0, 0);
        acc = __builtin_amdgcn_mfma_f32_16x16x32_bf16(a1, b1, acc, 0, 0, 0);
        u32x2 o; o.x = pk2(acc[0], acc[1]); o.y = pk2(acc[2], acc[3]);
        *(u32x2*)(Ut + (size_t)item * 16384 + (vt * 16 + fr) * 128 + k0 + 4 * fq) = o;
    }
    __syncthreads();
}

__device__ __forceinline__ void hgrn_h2(int e, bf16_t* Ut, const float* dec) {
    const int bh = e >> 13, rem = e & 8191, v = rem >> 6, k = (rem & 63) * 2;
    unsigned* up = (unsigned*)(Ut + (size_t)bh * 128 * 16384 + v * 128 + k);
    const float* dp = dec + (size_t)bh * 128 * 128 + k;
    float s0 = 0.f, s1 = 0.f;
    for (int c0 = 0; c0 < 128; c0 += 32) {
        unsigned uu[32]; float d0[32], d1[32];
#pragma unroll
        for (int i = 0; i < 32; ++i) { uu[i] = up[(size_t)(c0 + i) * 8192]; const float2 dd = *(const float2*)(dp + (size_t)(c0 + i) * 128); d0[i] = dd.x; d1[i] = dd.y; }
#pragma unroll
        for (int i = 0; i < 32; ++i) { up[(size_t)(c0 + i) * 8192] = pk2(s0, s1); s0 = d0[i] * s0 + bflo(uu[i]); s1 = d1[i] * s1 + bfhi(uu[i]); }
    }
}

__device__ __forceinline__ void hgrn_h3(const Args& a, LAS unsigned char* lds, int item, int tid_, const bf16_t* nat, const bf16_t* St, bf16_t* yb) {
    const int tid = opaque_tid();
    const int bh = item >> 7, c = item & 127, b = bh >> 2, h = bh & 3;
    const size_t row0 = (size_t)b * SEQ + (size_t)c * 64;
    LAS bf16_t* QD = (LAS bf16_t*)lds;
    LAS bf16_t* KD = QD + 64 * 136;
    LAS bf16_t* VT = KD + 64 * 136;
    LAS bf16_t* PS = VT + 128 * 72;
    LAS float* SEGT = (LAS float*)(lds + 62464);
    LAS float* OT = (LAS float*)(lds + 64512);
    const int k = tid & 127, seg = tid >> 7, t0 = seg * 16;
    const int w = tid >> 6, lane = tid & 63, fr = lane & 15, fq = lane >> 4, v0 = 16 * w;
    const bf16_t* base = nat + (row0 + t0) * NATW + h * 128 + k;
    bf16_t fraw[16], qraw[16], vraw[16];
#pragma unroll
    for (int i = 0; i < 16; ++i) { fraw[i] = base[(size_t)i * NATW + NC_F]; qraw[i] = base[(size_t)i * NATW + NC_Q]; vraw[i] = base[(size_t)i * NATW + NC_I]; }
    u32x4 ogq[2], zbq[2]; bf16x8 sb[4];
#pragma unroll
    for (int r = 0; r < 2; ++r) { const int oc = tid + 512 * r, t = oc >> 4, v8 = (oc & 15) * 8; const bf16_t* p = nat + (row0 + t) * NATW + h * 128 + v8; ogq[r] = *(const u32x4*)(p + NC_OG); zbq[r] = *(const u32x4*)(p + NC_ZB); }
#pragma unroll
    for (int ks = 0; ks < 4; ++ks) sb[ks] = *(const bf16x8*)(St + (size_t)item * 16384 + (v0 + fr) * 128 + ks * 32 + fq * 8);
    const float lbv = hgrn_lb(a.in[13], h * 128 + k), olb = 1.f - lbv;
    float g[16], key[16], qs[16], run = 0.f;
#pragma unroll
    for (int i = 0; i < 16; ++i) { const float f = fmaxf(bf2f(fraw[i]), -80.f); const float ef = __expf(-f); const float sg = __builtin_amdgcn_rcpf(1.f + ef);
        run += __logf(lbv + olb * sg); g[i] = run; key[i] = olb * ef * sg; const float q = bf2f(qraw[i]); qs[i] = q * __builtin_amdgcn_rcpf(1.f + __expf(-q)); }
    SEGT[seg * 128 + k] = run;
    { u32x4 w0, w1;
      w0.x = vraw[0] | ((unsigned)vraw[1] << 16); w0.y = vraw[2] | ((unsigned)vraw[3] << 16); w0.z = vraw[4] | ((unsigned)vraw[5] << 16); w0.w = vraw[6] | ((unsigned)vraw[7] << 16);
      w1.x = vraw[8] | ((unsigned)vraw[9] << 16); w1.y = vraw[10] | ((unsigned)vraw[11] << 16); w1.z = vraw[12] | ((unsigned)vraw[13] << 16); w1.w = vraw[14] | ((unsigned)vraw[15] << 16);
      *(LAS u32x4*)(VT + k * 72 + t0) = w0; *(LAS u32x4*)(VT + k * 72 + t0 + 8) = w1; }
    __syncthreads();
    { float off = 0.f;
#pragma unroll
      for (int j = 0; j < 3; ++j) { const float sj = SEGT[j * 128 + k]; if (j < seg) off += sj; }
#pragma unroll
      for (int i = 0; i < 16; ++i) { const float cum = off + g[i]; QD[(t0 + i) * 136 + k] = (bf16_t)f2bf(qs[i] * __expf(cum)); KD[(t0 + i) * 136 + k] = (bf16_t)f2bf(key[i] * __expf(-cum)); } }
    __syncthreads();
    {
        const int tt = w >> 1;
        bf16x8 qa[4];
#pragma unroll
        for (int ks = 0; ks < 4; ++ks) qa[ks] = *(const LAS bf16x8*)(QD + (tt * 16 + fr) * 136 + ks * 32 + fq * 8);
#pragma unroll
        for (int si = 0; si < 2; ++si) {
            const int st = 2 * (w & 1) + si;
            f32x4 acc = (f32x4){0.f, 0.f, 0.f, 0.f};
            if (st <= tt) {
#pragma unroll
                for (int ks = 0; ks < 4; ++ks) { const bf16x8 kb = *(const LAS bf16x8*)(KD + (st * 16 + fr) * 136 + ks * 32 + fq * 8); acc = __builtin_amdgcn_mfma_f32_16x16x32_bf16(qa[ks], kb, acc, 0, 0, 0); }
            }
#pragma unroll
            for (int j = 0; j < 4; ++j) { const int t = tt * 16 + 4 * fq + j, s = st * 16 + fr; PS[t * 72 + s] = (bf16_t)f2bf((s <= t) ? acc[j] : 0.f); }
        }
    }
    __syncthreads();
    {
        bf16x8 vb[2];
#pragma unroll
        for (int ks = 0; ks < 2; ++ks) vb[ks] = *(const LAS bf16x8*)(VT + (v0 + fr) * 72 + ks * 32 + fq * 8);
#pragma unroll
        for (int tt = 0; tt < 4; ++tt) {
            f32x4 acc = (f32x4){0.f, 0.f, 0.f, 0.f};
#pragma unroll
            for (int ks = 0; ks < 2; ++ks) { const bf16x8 pa = *(const LAS bf16x8*)(PS + (tt * 16 + fr) * 72 + ks * 32 + fq * 8); acc = __builtin_amdgcn_mfma_f32_16x16x32_bf16(pa, vb[ks], acc, 0, 0, 0); }
#pragma unroll
            for (int ks = 0; ks < 4; ++ks) { const bf16x8 qa = *(const LAS bf16x8*)(QD + (tt * 16 + fr) * 136 + ks * 32 + fq * 8); acc = __builtin_amdgcn_mfma_f32_16x16x32_bf16(qa, sb[ks], acc, 0, 0, 0); }
#pragma unroll
            for (int j = 0; j < 4; ++j) OT[(tt * 16 + 4 * fq + j) * 132 + v0 + fr] = acc[j];
        }
    }
    __syncthreads();
#pragma unroll
    for (int r = 0; r < 2; ++r) {
        const int oc = tid + 512 * r, t = oc >> 4, v8 = (oc & 15) * 8;
        const f32x4 o0 = *(const LAS f32x4*)(OT + t * 132 + v8), o1 = *(const LAS f32x4*)(OT + t * 132 + v8 + 4);
        float o[8];
        o[0] = o0[0] * sigmoidf_(bflo(ogq[r].x)); o[1] = o0[1] * sigmoidf_(bfhi(ogq[r].x)); o[2] = o0[2] * sigmoidf_(bflo(ogq[r].y)); o[3] = o0[3] * sigmoidf_(bfhi(ogq[r].y));
        o[4] = o1[0] * sigmoidf_(bflo(ogq[r].z)); o[5] = o1[1] * sigmoidf_(bfhi(ogq[r].z)); o[6] = o1[2] * sigmoidf_(bflo(ogq[r].w)); o[7] = o1[3] * sigmoidf_(bfhi(ogq[r].w));
        float ss = (o[0] * o[0] + o[1] * o[1]) + (o[2] * o[2] + o[3] * o[3]) + (o[4] * o[4] + o[5] * o[5]) + (o[6] * o[6] + o[7] * o[7]);
        ss += __shfl_xor(ss, 1); ss += __shfl_xor(ss, 2); ss += __shfl_xor(ss, 4); ss += __shfl_xor(ss, 8);
        const float rs = rsqrtf(ss * (1.f / 128.f) + NORM_EPS);
        const float* hwp = a.in[14] + h * 128 + v8; const f32x4 h0 = *(const f32x4*)hwp, h1 = *(const f32x4*)(hwp + 4);
        u32x4 wo;
        wo.x = pg8::cvt_pk_bf16(o[0] * rs * h0[0] * siluf_(bflo(zbq[r].x)), o[1] * rs * h0[1] * siluf_(bfhi(zbq[r].x)));
        wo.y = pg8::cvt_pk_bf16(o[2] * rs * h0[2] * siluf_(bflo(zbq[r].y)), o[3] * rs * h0[3] * siluf_(bfhi(zbq[r].y)));
        wo.z = pg8::cvt_pk_bf16(o[4] * rs * h1[0] * siluf_(bflo(zbq[r].z)), o[5] * rs * h1[1] * siluf_(bfhi(zbq[r].z)));
        wo.w = pg8::cvt_pk_bf16(o[6] * rs * h1[2] * siluf_(bflo(zbq[r].w)), o[7] * rs * h1[3] * siluf_(bfhi(zbq[r].w)));
        *(u32x4*)(yb + (row0 + t) * 512 + h * 128 + v8) = wo;
    }
    __syncthreads();
}

__device__ __forceinline__ void s5_carry(LAS unsigned char* lds, int item, int tid_, const float* hloc, bf16_t* as5, const float* misc) {
    const int tid = opaque_tid();
    const int b = item >> 5, g = item & 31, n = tid & 63, seg = tid >> 6;
    LAS float* E = (LAS float*)lds;
    const float* mp = misc + (size_t)(g * 64 + n) * 4;
    const float ar = mp[0], ai = mp[1], Ar = mp[2], Ai = mp[3];
    const size_t R0 = (size_t)g * 1024 + (size_t)b * 512 + (size_t)seg * 64;
    const float* hp = hloc + R0 * 128 + n;
    float hr = 0.f, hi = 0.f;
    for (int c0 = 0; c0 < 64; c0 += 16) {
        float lr[16], li[16];
#pragma unroll
        for (int i = 0; i < 16; ++i) { lr[i] = hp[(size_t)(c0 + i) * 128]; li[i] = hp[(size_t)(c0 + i) * 128 + 64]; }
#pragma unroll
        for (int i = 0; i < 16; ++i) { const float nr = ar * hr - ai * hi + lr[i], ni = ar * hi + ai * hr + li[i]; hr = nr; hi = ni; }
    }
    E[(seg * 64 + n) * 2] = hr; E[(seg * 64 + n) * 2 + 1] = hi;
    __syncthreads();
    hr = 0.f; hi = 0.f;
    for (int j = 0; j < seg; ++j) { const float er = E[(j * 64 + n) * 2], ei = E[(j * 64 + n) * 2 + 1]; const float nr = Ar * hr - Ai * hi + er, ni = Ar * hi + Ai * hr + ei; hr = nr; hi = ni; }
    bf16_t* op = as5 + R0 * 384 + 256 + n;
    for (int c0 = 0; c0 < 64; c0 += 16) {
        float lr[16], li[16];
#pragma unroll
        for (int i = 0; i < 16; ++i) { lr[i] = hp[(size_t)(c0 + i) * 128]; li[i] = hp[(size_t)(c0 + i) * 128 + 64]; }
#pragma unroll
        for (int i = 0; i < 16; ++i) { op[(size_t)(c0 + i) * 384] = (bf16_t)f2bf(hr); op[(size_t)(c0 + i) * 384 + 64] = (bf16_t)f2bf(hi);
            const float nr = ar * hr - ai * hi + lr[i], ni = ar * hi + ai * hr + li[i]; hr = nr; hi = ni; }
    }
    __syncthreads();
}

#if DBG_CHECK
__device__ __forceinline__ unsigned hash_u(unsigned x) { x ^= x >> 16; x *= 0x7feb352dU; x ^= x >> 15; x *= 0x846ca68bU; x ^= x >> 16; return x; }
__device__ __forceinline__ void chk_add(float* chk, int k, float opt, float ref, int lane) { if (lane == 0) { const float d = opt - ref; atomicAdd(chk + 2 * k, d * d); atomicAdd(chk + 2 * k + 1, ref * ref); } }
__device__ __forceinline__ float proj_ref(const Args& a, int t, int col, int lane) {
    const float* x = a.in[0] + (size_t)t * DM; float ss = 0.f;
    for (int j = lane; j < DM; j += 64) ss += x[j] * x[j];
    ss = wave_sum(ss); const float rstd = rsqrtf(ss * (1.f / DM) + NORM_EPS);
    float acc = 0.f;
    for (int j = lane; j < DM; j += 64) acc += x[j] * rstd * a.in[1][j] * a.in[2][(size_t)j * INW + col];
    return wave_sum(acc);
}
__device__ __forceinline__ void chk_proj(const Args& a, float* chk, int si, int lane, const bf16_t* as5, const bf16_t* nat) {
    const unsigned hsh = hash_u(si * 2 + 1); const int t = hsh % MTOK, col = (hsh >> 14) % INW;
    const float ref = proj_ref(a, t, col, lane); float opt;
    if (col < 512) { const int g = col >> 4, p = col & 15; opt = bf2f(as5[((size_t)(g * 1024 + (t >> 4))) * 384 + (t & 15) * 16 + p]); }
    else opt = bf2f(nat[(size_t)t * NATW + col - 512]);
    chk_add(chk, 1, opt, ref, lane);
}
__device__ __forceinline__ void chk_s5(const Args& a, float* chk, int si, int lane, const bf16_t* as5, const bf16_t* yg) {
    const unsigned hsh = hash_u(si * 2 + 77); const int b = hsh & 1, g = (hsh >> 1) & 31; int t = (hsh >> 6) % SEQ; if ((si & 3) == 0) t &= 63; if ((si & 3) == 1) t &= 1023;
    const int n = lane;
    const double dt = exp((double)a.in[10][g]);
    const double lr = (double)fminf(a.in[3][g * 64 + n], -1e-4f), li = (double)a.in[4][g * 64 + n];
    double are, aim; s5_pow(lr, li, dt, 1.0, are, aim);
    const double den = lr * lr + li * li, nr = are - 1.0;
    const double cr = (nr * lr + aim * li) / den, ci = (aim * lr - nr * li) / den;
    double bbr[16], bbi[16];
#pragma unroll
    for (int p = 0; p < 16; ++p) { const double br = (double)a.in[5][(g * 64 + n) * 16 + p], bi = (double)a.in[6][(g * 64 + n) * 16 + p]; bbr[p] = cr * br - ci * bi; bbi[p] = cr * bi + ci * br; }
    double hr = 0.0, hi = 0.0;
    for (int s = 0; s <= t; ++s) {
        const int tg = b * SEQ + s; const bf16_t* up = as5 + ((size_t)(g * 1024 + (tg >> 4))) * 384 + (tg & 15) * 16;
        const u32x4 w0 = *(const u32x4*)up, w1 = *(const u32x4*)(up + 8);
        float uf[16]; uf[0] = bflo(w0.x); uf[1] = bfhi(w0.x); uf[2] = bflo(w0.y); uf[3] = bfhi(w0.y); uf[4] = bflo(w0.z); uf[5] = bfhi(w0.z); uf[6] = bflo(w0.w); uf[7] = bfhi(w0.w);
        uf[8] = bflo(w1.x); uf[9] = bfhi(w1.x); uf[10] = bflo(w1.y); uf[11] = bfhi(w1.y); uf[12] = bflo(w1.z); uf[13] = bfhi(w1.z); uf[14] = bflo(w1.w); uf[15] = bfhi(w1.w);
        double br = 0.0, bi = 0.0;
#pragma unroll
        for (int p = 0; p < 16; ++p) { br += bbr[p] * (double)uf[p]; bi += bbi[p] * (double)uf[p]; }
        const double nhr = are * hr - aim * hi + br, nhi = are * hi + aim * hr + bi; hr = nhr; hi = nhi;
    }
    const int tg = b * SEQ + t;
    for (int p = 0; p < 16; ++p) {
        float y = (float)(hr * (double)a.in[7][(g * 16 + p) * 64 + n] - hi * (double)a.in[8][(g * 16 + p) * 64 + n]);
        y = wave_sum(y);
        y += a.in[9][g * 16 + p] * bf2f(as5[((size_t)(g * 1024 + (tg >> 4))) * 384 + (tg & 15) * 16 + p]);
        chk_add(chk, 2, bf2f(yg[(size_t)tg * 512 + g * 16 + p]), gelu_tanh(y), lane);
    }
}
__device__ __forceinline__ void chk_hgrn(const Args& a, float* chk, int si, int lane, const bf16_t* nat, const bf16_t* yb) {
    const unsigned hsh = hash_u(si * 2 + 1234567); const int b = hsh & 1, h = (hsh >> 1) & 3; int t = (hsh >> 4) % SEQ; if ((si & 3) == 0) t &= 255;
    const size_t rb = (size_t)b * SEQ;
    float q[2], D[2] = {1.f, 1.f}, o[2] = {0.f, 0.f}, lbv[2];
#pragma unroll
    for (int i = 0; i < 2; ++i) { const int k = lane + 64 * i; const float qq = bf2f(nat[(rb + t) * NATW + NC_Q + h * 128 + k]); q[i] = qq / (1.f + expf(-qq)); lbv[i] = hgrn_lb(a.in[13], h * 128 + k); }
    const int s_lo = t > 1023 ? t - 1023 : 0;
    for (int s = t; s >= s_lo; --s) {
        const bf16_t* r = nat + (rb + s) * NATW + h * 128; float w = 0.f, fg[2];
#pragma unroll
        for (int i = 0; i < 2; ++i) { const int k = lane + 64 * i; const float f = bf2f(r[NC_F + k]); fg[i] = lbv[i] + (1.f - lbv[i]) / (1.f + expf(-f)); w += q[i] * (1.f - fg[i]) * D[i]; }
        w = wave_sum(w);
#pragma unroll
        for (int i = 0; i < 2; ++i) { o[i] += w * bf2f(r[NC_I + lane + 64 * i]); D[i] *= fg[i]; }
    }
    float ss = 0.f;
#pragma unroll
    for (int i = 0; i < 2; ++i) { const float og = bf2f(nat[(rb + t) * NATW + NC_OG + h * 128 + lane + 64 * i]); o[i] = o[i] / (1.f + expf(-og)); ss += o[i] * o[i]; }
    ss = wave_sum(ss); const float rs = rsqrtf(ss * (1.f / 128.f) + NORM_EPS);
#pragma unroll
    for (int i = 0; i < 2; ++i) { const int vc = h * 128 + lane + 64 * i; const float zb = bf2f(nat[(rb + t) * NATW + NC_ZB + vc]); const float ref = o[i] * rs * a.in[14][vc] * (zb / (1.f + expf(-zb)));
        const float opt = bf2f(yb[(rb + t) * 512 + vc]); const float d = opt - ref; float n2 = wave_sum(d * d), r2 = wave_sum(ref * ref);
        if (lane == 0) { atomicAdd(chk + 6, n2); atomicAdd(chk + 7, r2); } }
}
__device__ __forceinline__ void chk_glu(const Args& a, float* chk, int si, int lane, const bf16_t* yg, const bf16_t* nat, const bf16_t* ya) {
    const unsigned hsh = hash_u(si * 2 + 999); const int t = hsh % MTOK, col = (hsh >> 14) & 511; float v = 0.f;
    for (int k = lane; k < 512; k += 64) v += bf2f(yg[(size_t)t * 512 + k]) * a.in[11][(size_t)k * 512 + col];
    v = wave_sum(v) + a.in[12][col];
    const float za = bf2f(nat[(size_t)t * NATW + NC_ZA + col]);
    const float ref = bf2f(yg[(size_t)t * 512 + col]) / (1.f + expf(-v)) * (za / (1.f + expf(-za)));
    chk_add(chk, 4, bf2f(ya[(size_t)t * 512 + col]), ref, lane);
}
__device__ __forceinline__ void chk_merge(const Args& a, float* chk, int si, int lane, const bf16_t* ya, const bf16_t* yb, const bf16_t* nat) {
    const unsigned hsh = hash_u(si * 2 + 31337); const int t = hsh % MTOK, n = (hsh >> 14) & 1023; float s1 = 0.f, s2 = 0.f;
    for (int k = lane; k < 512; k += 64) { s1 += bf2f(ya[(size_t)t * 512 + k]) * a.in[15][(size_t)k * DM + n]; s2 += bf2f(yb[(size_t)t * 512 + k]) * a.in[16][(size_t)k * DM + n]; }
    s1 = wave_sum(s1); s2 = wave_sum(s2);
    const float ga = bf2f(nat[(size_t)t * NATW + NC_GA + n]), gb = proj_ref(a, t, 512 + NC_GB + n, lane);
    const float ref = s1 / (1.f + expf(-ga)) + s2 / (1.f + expf(-gb));
    chk_add(chk, 5, bf2f(nat[(size_t)t * NATW + NC_GB + n]), ref, lane);
}
#endif


#define XB_TMO      128
#define XB_XCNT(j)  (256  + 64 * (j))
#define XB_XSUB(j)  (1280 + 64 * (j))
#define XB_XGEN(j)  (2304 + 64 * (j))
#define XB_TOP      3328
#define XB_TOPGEN   3392
#define XCD_BAR_WORDS 3456
#define XB_SPIN_CAP (1u << 22)
__device__ __forceinline__ unsigned xb_ld(unsigned* p)              { return __hip_atomic_load(p, __ATOMIC_RELAXED, __HIP_MEMORY_SCOPE_AGENT); }
__device__ __forceinline__ unsigned xb_add(unsigned* p, unsigned v) { return __hip_atomic_fetch_add(p, v, __ATOMIC_RELAXED, __HIP_MEMORY_SCOPE_AGENT); }
__device__ __forceinline__ unsigned xb_xcc_id() { return (unsigned)__builtin_amdgcn_s_getreg((3 << 11) | 20) & 0xFu; }
#define XB_SPIN(cond, bar) do { unsigned _sp = 0; while (cond) { __builtin_amdgcn_s_sleep(1); \
    if ((++_sp & 255u) == 0u) { if (xb_ld(&(bar)[XB_TMO])) break; if (_sp > XB_SPIN_CAP) { atomicAdd(&(bar)[XB_TMO], 1u); break; } } } } while (0)
struct XcdBarrier { unsigned* bar; unsigned x; volatile LAS unsigned* st; };
__device__ __forceinline__ XcdBarrier xcd_barrier_post(unsigned* bar, volatile LAS unsigned* st) {
    XcdBarrier b; b.bar = bar; b.x = xb_xcc_id(); b.st = st;
    if (threadIdx.x == 0) (void)xb_add(&bar[XB_XCNT(b.x)], 1u);
    return b;
}
__device__ __forceinline__ void xcd_barrier_complete(unsigned* bar, unsigned x, unsigned& nloc, unsigned& nx) {
    const unsigned G = gridDim.x * gridDim.y * gridDim.z;
    unsigned sum, cnt, mine, sp = 0u;
    for (;;) {
        sum = 0u; cnt = 0u; mine = 0u;
#pragma unroll
        for (unsigned j = 0; j < 16; ++j) { const unsigned c = xb_ld(&bar[XB_XCNT(j)]); sum += c; cnt += (c > 0u) ? 1u : 0u; mine = (j == x) ? c : mine; }
        if (sum == G) break;
        __builtin_amdgcn_s_sleep(1);
        if ((++sp & 255u) == 0u) { if (xb_ld(&bar[XB_TMO])) break; if (sp > XB_SPIN_CAP) { atomicAdd(&bar[XB_TMO], 1u); break; } }
    }
    nloc = mine > 0u ? mine : 1u; nx = cnt > 0u ? cnt : 1u;
}
__device__ __forceinline__ void xcd_barrier(const XcdBarrier& b) {
    asm volatile("s_waitcnt vmcnt(0)" ::: "memory");
    __syncthreads();
    if (threadIdx.x == 0) {
        unsigned* bar = b.bar;
        __builtin_amdgcn_s_waitcnt(0);
        unsigned nloc = b.st[0], nx = b.st[1];
        if (nloc == 0u) { xcd_barrier_complete(bar, b.x, nloc, nx); b.st[0] = nloc; b.st[1] = nx; }
        const unsigned old = xb_add(&bar[XB_XSUB(b.x)], 1u);
        const unsigned gen = old / nloc;
        if (old + 1u == (gen + 1u) * nloc) {
            __builtin_amdgcn_fence(__ATOMIC_RELEASE, "agent");
            asm volatile("s_waitcnt vmcnt(0)" ::: "memory");
            const unsigned og = xb_add(&bar[XB_TOP], 1u);
            const unsigned tg = og / nx;
            if (og + 1u == (tg + 1u) * nx) xb_add(&bar[XB_TOPGEN], 1u);
            else XB_SPIN(xb_ld(&bar[XB_TOPGEN]) == tg, bar);
            __builtin_amdgcn_fence(__ATOMIC_ACQUIRE, "agent");
            xb_add(&bar[XB_XGEN(b.x)], 1u);
            asm volatile("s_waitcnt vmcnt(0)" ::: "memory");
        } else {
            XB_SPIN(xb_ld(&bar[XB_XGEN(b.x)]) == gen, bar);
            __builtin_amdgcn_fence(__ATOMIC_ACQUIRE, "agent");
            asm volatile("s_waitcnt vmcnt(0)" ::: "memory");
        }
    }
    __syncthreads();
}

constexpr int LDS_BYTES = 147456;
__global__ void __launch_bounds__(512, 2) mega(Args a) {
    extern __shared__ __attribute__((aligned(16))) unsigned char lds_raw[];
    LAS unsigned char* lds = (LAS unsigned char*)lds_raw;
    cg::grid_group grid = cg::this_grid();
    const int tid = threadIdx.x, lane = tid & 63, wave = __builtin_amdgcn_readfirstlane(tid >> 6);
    const int G = gridDim.x, bx = blockIdx.x;
    const int gw = bx * 8 + wave, NGW = G * 8;
    unsigned char* ws = a.ws;
    float* chk = (float*)(ws + WS_CTL);
    volatile LAS unsigned* bst = (volatile LAS unsigned*)(lds + 140000);
    if (tid < 2) bst[tid] = 0u;
    __syncthreads();
    XcdBarrier xbar = xcd_barrier_post((unsigned*)(ws + WS_CTL) + 1024, bst);
    if (gridDim.x == 0x7fffffffu) grid.sync();
#define GRID_BAR() xcd_barrier(xbar)
    bf16_t* Win_t = (bf16_t*)(ws + WS_WIN); bf16_t* Wglu_t = (bf16_t*)(ws + WS_WGLU); bf16_t* Wpa_t = (bf16_t*)(ws + WS_WPA); bf16_t* Wpb_t = (bf16_t*)(ws + WS_WPB); bf16_t* Wout_t = (bf16_t*)(ws + WS_WOUT);
    bf16_t* TQ = (bf16_t*)(ws + WS_TQ); bf16_t* PP = (bf16_t*)(ws + WS_PP); float* misc = (float*)(ws + WS_MISC); float* rowss = (float*)(ws + WS_ROWSS);
    bf16_t* as5 = (bf16_t*)(ws + WS_AS5); bf16_t* ya = (bf16_t*)(ws + WS_AS5); bf16_t* yg = (bf16_t*)(ws + WS_YG); bf16_t* yb = (bf16_t*)(ws + WS_YB); bf16_t* nat = (bf16_t*)(ws + WS_NAT);
    unsigned char* ob = (unsigned char*)a.out;
    bf16_t* xn = (bf16_t*)(ob + DO_XN); bf16_t* Ut = (bf16_t*)(ob + DO_US); float* hloc = (float*)(ob + DO_HLOC); float* dec = (float*)(ob + DO_DEC);

    REP(0) if (PH(0)) {
        if (bx < 32) s5_build(a, bx, lds, tid, TQ, PP, misc);
        LAS float* scr = (LAS float*)(lds + wave * 16384);
        constexpr int I_IN = (DM / 64) * (INW / 32), I_GLU = (512 / 64) * (512 / 32), I_PA = (512 / 64) * (DM / 32), I_OUT = (DM / 64) * (DM / 32);
        constexpr int NITEMS = I_IN + I_GLU + 2 * I_PA + I_OUT;
        for (int it = gw; it < NITEMS; it += NGW) {
            int r = it;
            if (r < I_IN) { p0_transpose_item(a.in[2], DM, INW, Win_t, a.in[1], scr, r, lane); continue; } r -= I_IN;
            if (r < I_GLU) { p0_transpose_item(a.in[11], 512, 512, Wglu_t, nullptr, scr, r, lane); continue; } r -= I_GLU;
            if (r < I_PA) { p0_transpose_item(a.in[15], 512, DM, Wpa_t, nullptr, scr, r, lane); continue; } r -= I_PA;
            if (r < I_PA) { p0_transpose_item(a.in[16], 512, DM, Wpb_t, nullptr, scr, r, lane); continue; } r -= I_PA;
            p0_transpose_item(a.in[17], DM, DM, Wout_t, nullptr, scr, r, lane);
        }
        for (int m = gw; m < MTOK; m += NGW) {
            const f32x4* xr = (const f32x4*)(a.in[0] + (size_t)m * DM) + lane;
            f32x4 v[4]; float s = 0.f;
#pragma unroll
            for (int j = 0; j < 4; ++j) { v[j] = xr[64 * j]; s += (v[j].x * v[j].x + v[j].y * v[j].y) + (v[j].z * v[j].z + v[j].w * v[j].w); }
            const float rstd = rsqrtf(wave_sum(s) * (1.f / DM) + NORM_EPS);
            u32x2* o8 = (u32x2*)(xn + (size_t)m * DM) + lane;
#pragma unroll
            for (int j = 0; j < 4; ++j) { u32x2 o; o.x = pk2(v[j].x * rstd, v[j].y * rstd); o.y = pk2(v[j].z * rstd, v[j].w * rstd); o8[64 * j] = o; }
        }
    }
    GRID_BAR();
    if (PROBE_REP == 9) { for (int r_ = 0; r_ < 8; ++r_) GRID_BAR(); }
    REP(1) if (PH(1)) {
        pg8::Gemm g{xn, Win_t, DM, DM, DM}; pg8::StaticOrder S; S.init(MTOK, INW, G, bx);
        pg8::EpiG1 E{as5, nat};
        pg8::gemm_phase<pg8::EpiG1, pg8::StaticOrder>(lds, g, S, E);
    }
    GRID_BAR();
#if DBG_CHECK
    for (int si = gw; si < 4096; si += NGW) chk_proj(a, chk, si, lane, as5, nat);
#endif
    REP(2) if (PH(2)) {
        pg8::Gemm g{as5, PP, 384, 256, 256}; pg8::S5Order S{G, bx};
        pg8::EpiHloc E{hloc};
        pg8::gemm_phase<pg8::EpiHloc, pg8::S5Order>(lds, g, S, E);
        for (int it = bx; it < 1024; it += G) hgrn_h1(a, lds, it, tid, nat, Ut, dec);
    }
    GRID_BAR();
    if (PH(3)) {
        if (G > 64) {
            REP(3) for (int it = bx; it < 64; it += G) s5_carry(lds, it, tid, hloc, as5, misc);
            if (bx >= 64) for (int e = (bx - 64) * 512 + tid; e < 65536; e += (G - 64) * 512) hgrn_h2(e, Ut, dec);
        } else {
            for (int it = bx; it < 64; it += G) s5_carry(lds, it, tid, hloc, as5, misc);
            for (int e = bx * 512 + tid; e < 65536; e += G * 512) hgrn_h2(e, Ut, dec);
        }
    }
    GRID_BAR();
    REP(4) if (PH(4)) {
        pg8::Gemm g{as5, TQ, 384, 384, 384}; pg8::S5Order S{G, bx};
        pg8::EpiYg E{yg};
        pg8::gemm_phase<pg8::EpiYg, pg8::S5Order>(lds, g, S, E);
        for (int it = bx; it < 1024; it += G) hgrn_h3(a, lds, it, tid, nat, Ut, yb);
    }
    GRID_BAR();
#if DBG_CHECK
    for (int si = gw; si < 2048; si += NGW) chk_s5(a, chk, si, lane, as5, yg);
    for (int si = gw; si < 2048; si += NGW) chk_hgrn(a, chk, si, lane, nat, yb);
    GRID_BAR();
#endif
    REP(5) if (PH(5)) {
        pg8::Gemm g{yg, Wglu_t, 512, 512, 512}; pg8::StaticOrder S; S.init(MTOK, 512, G, bx);
        pg8::EpiGlu E{yg, nat, a.in[12], ya};
        pg8::gemm_phase<pg8::EpiGlu, pg8::StaticOrder>(lds, g, S, E);
    }
    GRID_BAR();
#if DBG_CHECK
    for (int si = gw; si < 4096; si += NGW) chk_glu(a, chk, si, lane, yg, nat, ya);
#endif
    if (PH(6)) {
        pg8::StaticOrder S; S.init(MTOK, DM, G, bx);
        REP(6) { pg8::Gemm g{ya, Wpa_t, 512, 512, 512}; pg8::EpiM1 E{nat, a.out}; pg8::gemm_phase<pg8::EpiM1, pg8::StaticOrder>(lds, g, S, E); }
        { pg8::Gemm g{yb, Wpb_t, 512, 512, 512}; pg8::EpiM2 E{nat, a.out}; pg8::gemm_phase<pg8::EpiM2, pg8::StaticOrder>(lds, g, S, E); }
    }
    GRID_BAR();
#if DBG_CHECK
    for (int si = gw; si < 4096; si += NGW) chk_merge(a, chk, si, lane, ya, yb, nat);
#endif
    REP(7) if (PH(7)) {
        pg8::Gemm g{nat + NC_GB, Wout_t, NATW, DM, DM}; pg8::StaticOrder S; S.init(MTOK, DM, G, bx);
        pg8::EpiOut E{a.in[0], a.out, rowss};
        pg8::gemm_phase<pg8::EpiOut, pg8::StaticOrder>(lds, g, S, E);
    }
    GRID_BAR();
    if (PH(8)) for (int m = gw; m < MTOK; m += NGW) {
        f32x4* hr = (f32x4*)(a.out + (size_t)m * DM) + lane;
        float tot = 0.f;
        { const float pv = (lane < 16) ? rowss[(size_t)m * 16 + lane] : 0.f; tot = wave_sum(pv); }
        const float rs = rsqrtf(tot * (1.f / DM) + NORM_EPS);
        const f32x4* fw = (const f32x4*)a.in[18] + lane;
#pragma unroll
        for (int j = 0; j < 4; ++j) { f32x4 v = hr[64 * j]; const f32x4 w = fw[64 * j]; v = v * rs * w; hr[64 * j] = v; }
    }
#if DBG_CHECK
    GRID_BAR();
    if (bx == 0 && tid == 0) {
        for (int k = 1; k <= 5; ++k) {
            const float num = chk[2 * k], den = chk[2 * k + 1]; const float err = sqrtf(num / (den + 1e-30f));
            if (!(err <= 0.03f)) { float e = err; if (!(e <= 0.9f)) e = 0.9f; a.out[0] += (float)(1 << (k + 2)) * (1.f + e); break; }
        }
    }
#endif
}

extern "C" void kernel_launch(void* const* d_in, const int* in_sizes, int n_in, void* d_out, int out_size, void* d_ws, size_t ws_size, hipStream_t stream) {
    static int grid = 0;
    if (grid == 0) {
        int dev = 0, cus = 0, per_cu = 0;
        hipGetDevice(&dev);
        hipDeviceGetAttribute(&cus, hipDeviceAttributeMultiprocessorCount, dev);
        if (hipFuncSetAttribute((const void*)mega, hipFuncAttributeMaxDynamicSharedMemorySize, LDS_BYTES) != hipSuccess) fprintf(stderr, "hipFuncSetAttribute failed\n");
        if (hipOccupancyMaxActiveBlocksPerMultiprocessor(&per_cu, (const void*)mega, 512, LDS_BYTES) != hipSuccess || per_cu < 1) { fprintf(stderr, "occupancy query: %d\n", per_cu); per_cu = 1; }
        (void)hipGetLastError();
        grid = cus * 1;
        if (n_in != 19 || ws_size < WS_END) fprintf(stderr, "kernel_launch: unexpected n_in %d / ws %zu\n", n_in, ws_size);
    }
    (void)hipMemsetAsync((char*)d_ws + WS_CTL, 0, 32768, stream);
    Args a{};
    for (int i = 0; i < 19; ++i) a.in[i] = (const float*)d_in[i];
    a.out = (float*)d_out; a.ws = (unsigned char*)d_ws;
    void* args[] = {&a};
    hipError_t e = hipLaunchCooperativeKernel((const void*)mega, dim3(grid), dim3(512), args, LDS_BYTES, stream);
    if (e != hipSuccess) fprintf(stderr, "cooperative launch failed: %s (grid %d)\n", hipGetErrorString(e), grid);
}
```
